# Optimizing an MI355X kernel written in HIP

```python
import math
import jax, jax.numpy as jnp
from jax import lax
import numpy as np

D_MODEL = 1024
BATCH = 2
SEQ = 8192
DEPTH = 2

GRID_W = 64
CTX_LEN = 256
ROPE_THETA = 10000.0
EPS = 1e-6
Q_BLOCK = 128

MLA_HEADS = 4
MLA_Q_RANK = 256
MLA_KV_RANK = 128
MLA_NOPE = 64
MLA_ROPE = 32
MLA_V = 64
DIFF_HEADS = 4
DIFF_QK = 32
DIFF_V = 2 * DIFF_QK
GQA_HEADS = 8
GQA_KV_HEADS = 2
GQA_DIM = 64
GQA_GROUP = GQA_HEADS // GQA_KV_HEADS

MIX_WIDTH = MLA_HEADS * MLA_V + DIFF_HEADS * DIFF_V + GQA_HEADS * GQA_DIM
FFN_HIDDEN = -(-8 * D_MODEL // (3 * 256)) * 256

IN_SIZES = (
    MLA_Q_RANK,
    MLA_KV_RANK + MLA_ROPE,
    DIFF_HEADS * 2 * DIFF_QK,
    DIFF_HEADS * 2 * DIFF_QK,
    DIFF_HEADS * DIFF_V,
    GQA_HEADS * GQA_DIM,
    GQA_KV_HEADS * GQA_DIM,
    GQA_KV_HEADS * GQA_DIM,
)
IN_WIDTH = sum(IN_SIZES)

MLA_SCALE = 1.0 / math.sqrt(MLA_NOPE + MLA_ROPE)
DIFF_SCALE = 1.0 / math.sqrt(DIFF_QK)
GQA_SCALE = 1.0 / math.sqrt(GQA_DIM)

kernel_name = "hymba_style_mla_diff_gqa_dit_block"


def _rms(x, g):
    xf = x.astype(jnp.float32)
    y = xf * lax.rsqrt(jnp.mean(xf * xf, axis=-1, keepdims=True) + EPS)
    return (y * g.astype(jnp.float32)).astype(x.dtype)


def _axial_rope_tables(row, col, rot_dim):
    quarter = rot_dim // 4
    inv = ROPE_THETA ** (-jnp.arange(quarter, dtype=jnp.float32) / quarter)
    ang = jnp.concatenate([row.astype(jnp.float32)[:, None] * inv,
                           col.astype(jnp.float32)[:, None] * inv], axis=-1)
    return jnp.cos(ang), jnp.sin(ang)


def _rope(x, tables):
    if tables is None:
        return x
    cos, sin = tables
    half = x.shape[-1] // 2
    xf = x.astype(jnp.float32)
    x1, x2 = xf[..., :half], xf[..., half:]
    c = cos[None, :, None, :]
    s = sin[None, :, None, :]
    return jnp.concatenate([x1 * c - x2 * s, x2 * c + x1 * s], axis=-1).astype(x.dtype)


def _hf(t):
    return t.transpose(0, 2, 1, 3)


def _sdpa(q, k, v, scale):
    s = jnp.einsum('bhgqd,bhkd->bhgqk', q, k).astype(jnp.float32) * scale
    p = jax.nn.softmax(s, axis=-1).astype(v.dtype)
    return jnp.einsum('bhgqk,bhkd->bhgqd', p, v)


def _latent_attention(q, k, v, scale):
    B, Hk, G, S, d = q.shape
    nb = S // Q_BLOCK
    qb = q.reshape(B, Hk, G, nb, Q_BLOCK, d).transpose(3, 0, 1, 2, 4, 5)
    ob = lax.map(lambda qi: _sdpa(qi, k, v, scale), qb)
    return ob.transpose(1, 2, 3, 0, 4, 5).reshape(B, Hk, G, S, ob.shape[-1])


def _project(h, w_in, g_mla_q, w_mla_qb, g_mla_kv, w_mla_kvb, g_gqa_q, g_gqa_k,
             rope_small, rope_large):
    B, T, _ = h.shape
    p = h @ w_in
    idx = np.cumsum(IN_SIZES)[:-1].tolist()
    q_a, kv_a, dq, dk, dv, gq, gk, gv = jnp.split(p, idx, axis=-1)

    q = (_rms(q_a, g_mla_q) @ w_mla_qb).reshape(B, T, MLA_HEADS, MLA_NOPE + MLA_ROPE)
    q_nope, q_pe = q[..., :MLA_NOPE], _rope(q[..., MLA_NOPE:], rope_small)
    c_kv = kv_a[..., :MLA_KV_RANK]
    k_pe = _rope(kv_a[..., MLA_KV_RANK:][:, :, None, :], rope_small)
    kv = (_rms(c_kv, g_mla_kv) @ w_mla_kvb).reshape(B, T, MLA_HEADS, MLA_NOPE + MLA_V)
    k_nope, v_mla = kv[..., :MLA_NOPE], kv[..., MLA_NOPE:]
    q_mla = jnp.concatenate([q_nope, q_pe], axis=-1)
    k_mla = jnp.concatenate([k_nope, jnp.broadcast_to(k_pe, (B, T, MLA_HEADS, MLA_ROPE))], axis=-1)
    mla = (_hf(q_mla)[:, :, None], _hf(k_mla), _hf(v_mla))

    q_d = _rope(dq.reshape(B, T, DIFF_HEADS * 2, DIFF_QK), rope_small)
    k_d = _rope(dk.reshape(B, T, DIFF_HEADS * 2, DIFF_QK), rope_small)
    v_d = jnp.repeat(dv.reshape(B, T, DIFF_HEADS, DIFF_V), 2, axis=2)
    diff = (_hf(q_d)[:, :, None], _hf(k_d), _hf(v_d))

    q_g = _rope(_rms(gq.reshape(B, T, GQA_HEADS, GQA_DIM), g_gqa_q), rope_large)
    k_g = _rope(_rms(gk.reshape(B, T, GQA_KV_HEADS, GQA_DIM), g_gqa_k), rope_large)
    v_g = gv.reshape(B, T, GQA_KV_HEADS, GQA_DIM)
    q_g = q_g.reshape(B, T, GQA_KV_HEADS, GQA_GROUP, GQA_DIM).transpose(0, 2, 3, 1, 4)
    gqa = (q_g, _hf(k_g), _hf(v_g))
    return (mla, diff, gqa)


def _merge(o_mla, o_diff, o_gqa, lam, lam_init, g_diff_sub):
    B, _, _, T, _ = o_mla.shape
    y_mla = o_mla[:, :, 0].transpose(0, 2, 1, 3).reshape(B, T, MLA_HEADS * MLA_V)
    od = o_diff[:, :, 0].reshape(B, DIFF_HEADS, 2, T, DIFF_V)
    d = od[:, :, 0] - lam.astype(od.dtype) * od[:, :, 1]
    d = _rms(d, g_diff_sub) * (1.0 - lam_init)
    y_diff = d.transpose(0, 2, 1, 3).reshape(B, T, DIFF_HEADS * DIFF_V)
    y_gqa = o_gqa.transpose(0, 3, 1, 2, 4).reshape(B, T, GQA_HEADS * GQA_DIM)
    return jnp.concatenate([y_mla, y_diff, y_gqa], axis=-1)


def _swiglu(h, w_gate, w_up, w_down):
    return (jax.nn.silu(h @ w_gate) * (h @ w_up)) @ w_down


def setup_inputs(seed: int = 0) -> dict:
    key = jax.random.key(seed)
    ks = iter(jax.random.split(key, 32))

    def nrm(shape, scale):
        return jax.random.normal(next(ks), shape, jnp.float32) * scale

    def gain(shape):
        return 1.0 + 0.05 * jax.random.normal(next(ks), shape, jnp.float32)

    D = D_MODEL
    return {
        "x": nrm((BATCH, SEQ, D), 1.0),
        "c": nrm((BATCH, D), 1.0),
        "ctx": nrm((BATCH, CTX_LEN, D), 1.0),
        "c_ctx": nrm((D,), 1.0),
        "w_ada": nrm((DEPTH, D, 6 * D), 0.5 * D ** -0.5),
        "b_ada": nrm((DEPTH, 6 * D), 0.01),
        "g_attn_pre": gain((DEPTH, D)),
        "g_attn_post": gain((DEPTH, D)),
        "w_in": nrm((DEPTH, D, IN_WIDTH), D ** -0.5),
        "g_mla_q": gain((DEPTH, MLA_Q_RANK)),
        "w_mla_qb": nrm((DEPTH, MLA_Q_RANK, MLA_HEADS * (MLA_NOPE + MLA_ROPE)), MLA_Q_RANK ** -0.5),
        "g_mla_kv": gain((DEPTH, MLA_KV_RANK)),
        "w_mla_kvb": nrm((DEPTH, MLA_KV_RANK, MLA_HEADS * (MLA_NOPE + MLA_V)), MLA_KV_RANK ** -0.5),
        "lambda_q1": nrm((DEPTH, DIFF_QK), 0.1),
        "lambda_k1": nrm((DEPTH, DIFF_QK), 0.1),
        "lambda_q2": nrm((DEPTH, DIFF_QK), 0.1),
        "lambda_k2": nrm((DEPTH, DIFF_QK), 0.1),
        "g_diff_sub": gain((DEPTH, DIFF_V)),
        "g_gqa_q": gain((DEPTH, GQA_DIM)),
        "g_gqa_k": gain((DEPTH, GQA_DIM)),
        "w_out": nrm((DEPTH, MIX_WIDTH, D), MIX_WIDTH ** -0.5),
        "g_ffn_pre": gain((DEPTH, D)),
        "g_ffn_post": gain((DEPTH, D)),
        "w_ffn_gate": nrm((DEPTH, D, FFN_HIDDEN), D ** -0.5),
        "w_ffn_up": nrm((DEPTH, D, FFN_HIDDEN), D ** -0.5),
        "w_ffn_down": nrm((DEPTH, FFN_HIDDEN, D), FFN_HIDDEN ** -0.5),
    }


def reference(x, c, ctx, c_ctx, w_ada, b_ada, g_attn_pre, g_attn_post, w_in, g_mla_q, w_mla_qb,
              g_mla_kv, w_mla_kvb, lambda_q1, lambda_k1, lambda_q2, lambda_k2, g_diff_sub,
              g_gqa_q, g_gqa_k, w_out, g_ffn_pre, g_ffn_post, w_ffn_gate, w_ffn_up, w_ffn_down):
    n_tok = x.shape[1]
    rows = n_tok // GRID_W
    row = jnp.repeat(jnp.arange(rows, dtype=jnp.int32), GRID_W)
    col = jnp.tile(jnp.arange(GRID_W, dtype=jnp.int32), rows)
    rope_small = _axial_rope_tables(row, col, MLA_ROPE)
    rope_large = _axial_rope_tables(row, col, GQA_DIM)

    silu_c = jax.nn.silu(c)
    silu_cc = jax.nn.silu(c_ctx)
    xc = ctx
    scales = (MLA_SCALE, DIFF_SCALE, GQA_SCALE)

    for l in range(DEPTH):
        last = l == DEPTH - 1
        mod = (silu_c @ w_ada[l] + b_ada[l])[:, None, :]
        mod_c = (silu_cc @ w_ada[l] + b_ada[l])[None, None, :]
        sh_a, sc_a, gt_a, sh_f, sc_f, gt_f = jnp.split(mod, 6, axis=-1)
        csh_a, csc_a, cgt_a, csh_f, csc_f, cgt_f = jnp.split(mod_c, 6, axis=-1)

        lam_init = 0.8 - 0.6 * math.exp(-0.3 * l)
        lam = (jnp.exp(jnp.sum(lambda_q1[l].astype(jnp.float32) * lambda_k1[l].astype(jnp.float32)))
               - jnp.exp(jnp.sum(lambda_q2[l].astype(jnp.float32) * lambda_k2[l].astype(jnp.float32)))
               + lam_init)

        h = _rms(x, g_attn_pre[l]) * (1.0 + sc_a) + sh_a
        hc = _rms(xc, g_attn_pre[l]) * (1.0 + csc_a) + csh_a
        proj_args = (w_in[l], g_mla_q[l], w_mla_qb[l], g_mla_kv[l], w_mla_kvb[l], g_gqa_q[l], g_gqa_k[l])
        lat = _project(h, *proj_args, rope_small, rope_large)
        cxt = _project(hc, *proj_args, None, None)

        o_lat = []
        for (q, k, v), (qc, kc, vc), s in zip(lat, cxt, scales):
            k_all = jnp.concatenate([k, kc], axis=2)
            v_all = jnp.concatenate([v, vc], axis=2)
            o_lat.append(_latent_attention(q, k_all, v_all, s))
        y = _merge(o_lat[0], o_lat[1], o_lat[2], lam, lam_init, g_diff_sub[l]) @ w_out[l]
        x = x + gt_a * _rms(y, g_attn_post[l])

        if not last:
            o_ctx = [_sdpa(qc, kc, vc, s) for (qc, kc, vc), s in zip(cxt, scales)]
            yc = _merge(o_ctx[0], o_ctx[1], o_ctx[2], lam, lam_init, g_diff_sub[l]) @ w_out[l]
            xc = xc + cgt_a * _rms(yc, g_attn_post[l])

        hf = _rms(x, g_ffn_pre[l]) * (1.0 + sc_f) + sh_f
        x = x + gt_f * _rms(_swiglu(hf, w_ffn_gate[l], w_ffn_up[l], w_ffn_down[l]), g_ffn_post[l])
        if not last:
            hfc = _rms(xc, g_ffn_pre[l]) * (1.0 + csc_f) + csh_f
            xc = xc + cgt_f * _rms(_swiglu(hfc, w_ffn_gate[l], w_ffn_up[l], w_ffn_down[l]), g_ffn_post[l])

    return x
```

```cpp
#include <hip/hip_runtime.h>
#include <hip/hip_cooperative_groups.h>
#include <stdint.h>
#include <stdio.h>
#include <string.h>
namespace cg = cooperative_groups;

#ifndef ONE_LAUNCH
#define ONE_LAUNCH 1
#endif

typedef unsigned short bf16_t;
typedef short bf16x8 __attribute__((ext_vector_type(8)));
typedef float f32x16 __attribute__((ext_vector_type(16)));
typedef float f32x4 __attribute__((ext_vector_type(4)));
typedef float f32x2 __attribute__((ext_vector_type(2)));
typedef unsigned u32x4 __attribute__((ext_vector_type(4)));
typedef unsigned u32x2 __attribute__((ext_vector_type(2)));

constexpr int DM = 1024, NB = 2, SEQ = 8192, CTXL = 256, NKEY = SEQ + CTXL, NLAT = NB * SEQ, NT = NLAT + NB * CTXL;
constexpr int FFN = 2816, INW = 2048, DEPTH = 2;
constexpr float EPS = 1e-6f, LOG2E = 1.4426950408889634f;
constexpr float MLA_SC = 0.10206207261596577f * LOG2E, DIFF_SC = 0.17677669529663687f * LOG2E, GQA_SC = 0.125f * LOG2E;
constexpr int LDS_BYTES = 73728;
constexpr int NTHREADS = 256;

struct Params {
    const float *x, *c, *ctx, *c_ctx, *w_ada, *b_ada, *g_attn_pre, *g_attn_post, *w_in, *g_mla_q, *w_mla_qb, *g_mla_kv, *w_mla_kvb,
        *lq1, *lk1, *lq2, *lk2, *g_diff_sub, *g_gqa_q, *g_gqa_k, *w_out, *g_ffn_pre, *g_ffn_post, *w_gate, *w_up, *w_down;
    float* out;
    bf16_t *wt_in, *wt_qb, *wt_kvb, *wt_out, *wt_gu, *wt_down;
    float *adapart, *mod, *lam, *cs16, *cs32, *xc, *ssq, *Yf;
    bf16_t *hbuf, *qkva, *Qm, *Km, *VmT, *Qd, *Kd, *VdT, *Qg, *Kg, *VgT, *Gact;
    unsigned* counters;
    int phase_begin, phase_end, coop, pad;
};

typedef __bf16 bf16x2_t __attribute__((ext_vector_type(2)));
__device__ __forceinline__ unsigned pk_bf16(float lo, float hi) { const f32x2 v = {lo, hi}; const bf16x2_t b = __builtin_convertvector(v, bf16x2_t); return __builtin_bit_cast(unsigned, b); }
__device__ __forceinline__ int otid() { int t = threadIdx.x; asm volatile("" : "+v"(t)); return t; }
__device__ __forceinline__ float fexp2(float x) { return __builtin_amdgcn_exp2f(x); }
__device__ __forceinline__ float max3f(float a, float b, float c) { float r; asm("v_max3_f32 %0, %1, %2, %3" : "=v"(r) : "v"(a), "v"(b), "v"(c)); return r; }
__device__ __forceinline__ float xhalf_max(float x) { return fmaxf(x, __shfl_xor(x, 32)); }
__device__ __forceinline__ float xhalf_sum(float x) { return x + __shfl_xor(x, 32); }
__device__ __forceinline__ float frsq(float x) { return __builtin_amdgcn_rsqf(x); }
__device__ __forceinline__ float wave_sum(float v) {
#pragma unroll
    for (int o = 32; o >= 1; o >>= 1) v += __shfl_xor(v, o);
    return v;
}
__device__ __forceinline__ void tok_decode(int t, int& b, int& j) { if (t < NLAT) { b = t >> 13; j = t & (SEQ - 1); } else { const int c = t - NLAT; b = c >> 8; j = SEQ + (c & (CTXL - 1)); } }
__device__ __forceinline__ const float* xin_row(const Params& p, int l, int t) {
    if (l == 0) return t < NLAT ? p.x + (size_t)t * DM : p.ctx + (size_t)(t - NLAT) * DM;
    return t < NLAT ? p.out + (size_t)t * DM : p.xc + (size_t)(t - NLAT) * DM;
}
__device__ __forceinline__ float* xw_row(const Params& p, int t) { return t < NLAT ? p.out + (size_t)t * DM : p.xc + (size_t)(t - NLAT) * DM; }
__device__ __forceinline__ int mod_vec(int t) { return t < NLAT ? (t >> 13) : 2; }

#define LASP __attribute__((address_space(3)))
typedef float f32x4acc __attribute__((ext_vector_type(4)));
template <class Epi>
__device__ __forceinline__ void gemm_tile(unsigned char* lds, const bf16_t* __restrict__ W, int ldw, const bf16_t* __restrict__ A, int lda, int K, int n0, int t0, const Epi& epi) {
    const int tid = otid(), lane = tid & 63, wid = tid >> 6, wn = wid >> 1, wt = wid & 1;
    const int dr = lane >> 3, dp = lane & 7;
    unsigned woff[4], aoff[4];
#pragma unroll
    for (int j = 0; j < 4; ++j) { const int row = (wid * 4 + j) * 8 + dr, c = dp ^ ((row >> 1) & 7);
        woff[j] = (unsigned)((n0 + row) * ldw + c * 8); aoff[j] = (unsigned)((t0 + row) * lda + c * 8); }
    const unsigned lbase = (unsigned)(size_t)lds + (unsigned)wid * 4096u;
    f32x4 acc[4][4];
#pragma unroll
    for (int a = 0; a < 4; ++a)
#pragma unroll
        for (int b = 0; b < 4; ++b) acc[a][b] = (f32x4){0.f, 0.f, 0.f, 0.f};
#define GT_DMA(kt_, st_) do { _Pragma("unroll") for (int j = 0; j < 4; ++j) { \
        __builtin_amdgcn_global_load_lds((const unsigned*)(W + woff[j] + (size_t)(kt_) * 64), (LASP unsigned*)(lbase + (unsigned)(st_) * 32768u + (unsigned)j * 1024u), 16, 0, 0); \
        __builtin_amdgcn_global_load_lds((const unsigned*)(A + aoff[j] + (size_t)(kt_) * 64), (LASP unsigned*)(lbase + (unsigned)(st_) * 32768u + 16384u + (unsigned)j * 1024u), 16, 0, 0); } } while (0)
    const int r16 = lane & 15, q = lane >> 4, sw = r16 >> 1;
    const int base_w = (wn * 64 + r16) * 128, base_a = 16384 + (wt * 64 + r16) * 128;
    const int nk = K >> 6;
    GT_DMA(0, 0);
    asm volatile("s_waitcnt vmcnt(0)" ::: "memory");
    __syncthreads();
    for (int kt = 0; kt < nk; ++kt) {
        const int st = kt & 1;
        if (kt + 1 < nk) GT_DMA(kt + 1, st ^ 1);
        const unsigned char* sb = lds + st * 32768;
#pragma unroll
        for (int ks = 0; ks < 2; ++ks) {
            const int pos = ((ks * 4 + q) ^ sw) * 16;
            bf16x8 fa[4], fb[4];
#pragma unroll
            for (int i = 0; i < 4; ++i) { fa[i] = *(const bf16x8*)(sb + base_w + i * 2048 + pos); fb[i] = *(const bf16x8*)(sb + base_a + i * 2048 + pos); }
#pragma unroll
            for (int ni = 0; ni < 4; ++ni)
#pragma unroll
                for (int ti = 0; ti < 4; ++ti) acc[ni][ti] = __builtin_amdgcn_mfma_f32_16x16x32_bf16(fa[ni], fb[ti], acc[ni][ti], 0, 0, 0);
        }
        asm volatile("s_waitcnt vmcnt(0)" ::: "memory");
        __syncthreads();
    }
#undef GT_DMA
    epi(acc, n0 + wn * 64, t0 + wt * 64, lane);
}

__device__ __forceinline__ bool gemm_unit(int u, int ntt, int nn, int& tt, int& nt) {
    const int xcd = u & 7, v = u >> 3; nt = v % nn; tt = (v / nn) * 8 + xcd; return tt < ntt;
}
__device__ __forceinline__ void store4(bf16_t* dst, const f32x4& v);
__device__ __forceinline__ void gemm_tile_small(unsigned char* lds, const bf16_t* __restrict__ W, int ldw, const bf16_t* __restrict__ A, int lda, int K, int n0, int t0, bf16_t* O, int ldo) {
    const int tid = otid(), lane = tid & 63, wid = tid >> 6;
    const int dr = lane >> 3, dp = lane & 7;
    unsigned woff[4], aoff;
#pragma unroll
    for (int j = 0; j < 4; ++j) { const int row = (wid * 4 + j) * 8 + dr, c = dp ^ ((row >> 1) & 7); woff[j] = (unsigned)((n0 + row) * ldw + c * 8); }
    { const int row = wid * 8 + dr, c = dp ^ ((row >> 1) & 7); aoff = (unsigned)((t0 + row) * lda + c * 8); }
    const unsigned lbase = (unsigned)(size_t)lds;
    f32x4 acc[2][2];
#pragma unroll
    for (int a = 0; a < 2; ++a) { acc[a][0] = (f32x4){0.f, 0.f, 0.f, 0.f}; acc[a][1] = (f32x4){0.f, 0.f, 0.f, 0.f}; }
#define GS_DMA(kt_, st_) do { _Pragma("unroll") for (int j = 0; j < 4; ++j) \
        __builtin_amdgcn_global_load_lds((const unsigned*)(W + woff[j] + (size_t)(kt_) * 64), (LASP unsigned*)(lbase + (unsigned)(st_) * 32768u + (unsigned)wid * 4096u + (unsigned)j * 1024u), 16, 0, 0); \
        __builtin_amdgcn_global_load_lds((const unsigned*)(A + aoff + (size_t)(kt_) * 64), (LASP unsigned*)(lbase + (unsigned)(st_) * 32768u + 16384u + (unsigned)wid * 1024u), 16, 0, 0); } while (0)
    const int r16 = lane & 15, q = lane >> 4, sw = r16 >> 1;
    const int base_w = (wid * 32 + r16) * 128, base_a = 16384 + r16 * 128;
    const int nk = K >> 6;
    GS_DMA(0, 0);
    asm volatile("s_waitcnt vmcnt(0)" ::: "memory");
    __syncthreads();
    for (int kt = 0; kt < nk; ++kt) {
        const int st = kt & 1;
        if (kt + 1 < nk) GS_DMA(kt + 1, st ^ 1);
        const unsigned char* sb = lds + st * 32768;
#pragma unroll
        for (int ks = 0; ks < 2; ++ks) {
            const int pos = ((ks * 4 + q) ^ sw) * 16;
            bf16x8 fa[2], fb[2];
#pragma unroll
            for (int i = 0; i < 2; ++i) { fa[i] = *(const bf16x8*)(sb + base_w + i * 2048 + pos); fb[i] = *(const bf16x8*)(sb + base_a + i * 2048 + pos); }
#pragma unroll
            for (int ni = 0; ni < 2; ++ni)
#pragma unroll
                for (int ti = 0; ti < 2; ++ti) acc[ni][ti] = __builtin_amdgcn_mfma_f32_16x16x32_bf16(fa[ni], fb[ti], acc[ni][ti], 0, 0, 0);
        }
        asm volatile("s_waitcnt vmcnt(0)" ::: "memory");
        __syncthreads();
    }
#undef GS_DMA
#pragma unroll
    for (int ti = 0; ti < 2; ++ti) { bf16_t* row = O + (size_t)(t0 + ti * 16 + r16) * ldo + n0 + wid * 32 + 4 * q;
#pragma unroll
        for (int ni = 0; ni < 2; ++ni) store4(row + ni * 16, acc[ni][ti]); }
}
__device__ __forceinline__ void gemm_phase_n1024(unsigned char* lds, const bf16_t* W, int ldw, const bf16_t* A, int lda, int K, bool with_ctx, bf16_t* O);

template <class Epi>
__device__ __forceinline__ void gemm_phase(unsigned char* lds, const bf16_t* W, int ldw, const bf16_t* A, int lda, int K, int ntt, int nn, const Epi& epi) {
    const int x = blockIdx.x & 7, j = blockIdx.x >> 3, stride = gridDim.x >> 3;
    const int ntx = (ntt - x + 7) >> 3;
    const int total = ntx * nn;
    for (int i = j; i < total; i += stride) {
        int tg = 0, rem = i;
        for (;;) { const int tc = min(8, ntx - 8 * tg); if (rem < tc * nn) break; rem -= tc * nn; ++tg; }
        const int tc = min(8, ntx - 8 * tg);
        const int ng = rem / (tc * 8), r2 = rem - ng * tc * 8;
        const int nl = r2 / tc, tl = r2 - nl * tc;
        const int nt = ng * 8 + nl, tt = (tg * 8 + tl) * 8 + x;
        gemm_tile(lds, W, ldw, A, lda, K, nt * 128, tt * 128, epi);
    }
}

__device__ __forceinline__ void store4(bf16_t* dst, const f32x4& v) { u32x2 w; w.x = pk_bf16(v[0], v[1]); w.y = pk_bf16(v[2], v[3]); *(u32x2*)dst = w; }
__device__ __forceinline__ float quad_sum(float v) { v += __shfl_xor(v, 16); v += __shfl_xor(v, 32); return v; }
__device__ __forceinline__ float sumsq4(const f32x4& v) { return v[0] * v[0] + v[1] * v[1] + v[2] * v[2] + v[3] * v[3]; }
__device__ __forceinline__ void rope4(f32x4& x1, f32x4& x2, const float* cs) {
    const f32x4 c01 = *(const f32x4*)cs, c23 = *(const f32x4*)(cs + 4);
    const f32x4 cc = {c01[0], c01[2], c23[0], c23[2]}, sn = {c01[1], c01[3], c23[1], c23[3]};
    const f32x4 a = x1 * cc - x2 * sn, b = x2 * cc + x1 * sn; x1 = a; x2 = b;
}

struct EpiInProj {
    const Params* pp; int l;
    __device__ __forceinline__ void operator()(f32x4 (&acc)[4][4], int nb0, int tb0, int lane) const {
        const Params& p = *pp; const int q = lane >> 4, r16 = lane & 15;
#pragma unroll
        for (int ti = 0; ti < 4; ++ti) {
            const int t = tb0 + ti * 16 + r16; int b, j; tok_decode(t, b, j); const bool lat = j < SEQ;
            if (nb0 < 384) {
                float ss = 0.f;
#pragma unroll
                for (int ni = 0; ni < 4; ++ni) { ss += sumsq4(acc[ni][ti]); store4(p.qkva + (size_t)t * 384 + nb0 + ni * 16 + 4 * q, acc[ni][ti]); }
                ss = quad_sum(ss);
                if (q == 0) p.ssq[(size_t)t * 8 + (nb0 >> 6)] = ss;
            } else if (nb0 < 896) {
                const bool isq = nb0 < 640;
#pragma unroll
                for (int mp = 0; mp < 2; ++mp) { f32x4 x1 = acc[2 * mp][ti], x2 = acc[2 * mp + 1][ti];
                    if (lat) rope4(x1, x2, p.cs16 + ((size_t)j * 16 + 4 * q) * 2);
                    if (isq) { x1 *= DIFF_SC; x2 *= DIFF_SC; }
                    const int map = ((nb0 - (isq ? 384 : 640)) >> 5) + mp;
                    bf16_t* dst = (isq ? p.Qd : p.Kd) + ((size_t)(b * 8 + map) * NKEY + j) * 32 + 4 * q;
                    store4(dst, x1); store4(dst + 16, x2); }
            } else if (nb0 < 1152 || (nb0 >= 1792 && nb0 < 1920)) {
                const bool isd = nb0 < 1152; const int hd = isd ? (nb0 - 896) >> 6 : (nb0 - 1792) >> 6;
                bf16_t* base = (isd ? p.VdT + (size_t)(b * 4 + hd) * 64 * NKEY : p.VgT + (size_t)(b * 2 + hd) * 64 * NKEY) + j;
#pragma unroll
                for (int ni = 0; ni < 4; ++ni)
#pragma unroll
                    for (int e = 0; e < 4; ++e) base[(size_t)(ni * 16 + 4 * q + e) * NKEY] = (bf16_t)(pk_bf16(acc[ni][ti][e], 0.f) & 0xffffu);
            } else if (nb0 < 1792) {
                const bool isq = nb0 < 1664; const int head = isq ? (nb0 - 1152) >> 6 : (nb0 - 1664) >> 6;
                const float* g = (isq ? p.g_gqa_q : p.g_gqa_k) + l * 64;
                float ss = 0.f;
#pragma unroll
                for (int ni = 0; ni < 4; ++ni) ss += sumsq4(acc[ni][ti]);
                ss = quad_sum(ss);
                const float rinv = frsq(ss * (1.f / 64.f) + EPS);
                bf16_t* dst = (isq ? p.Qg + ((size_t)(b * 8 + head) * NKEY + j) * 64 : p.Kg + ((size_t)(b * 2 + head) * NKEY + j) * 64);
#pragma unroll
                for (int mp = 0; mp < 2; ++mp) { const int d0 = mp * 16 + 4 * q;
                    f32x4 x1 = acc[mp][ti] * rinv * *(const f32x4*)(g + d0), x2 = acc[mp + 2][ti] * rinv * *(const f32x4*)(g + 32 + d0);
                    if (lat) rope4(x1, x2, p.cs32 + ((size_t)j * 32 + d0) * 2);
                    if (isq) { x1 *= GQA_SC; x2 *= GQA_SC; }
                    store4(dst + d0, x1); store4(dst + 32 + d0, x2); }
            } else if (nb0 == 1920) {
                f32x4 x1 = acc[0][ti], x2 = acc[1][ti];
                if (lat) rope4(x1, x2, p.cs16 + ((size_t)j * 16 + 4 * q) * 2);
#pragma unroll
                for (int hh = 0; hh < 4; ++hh) { bf16_t* dst = p.Km + ((size_t)(b * 4 + hh) * NKEY + j) * 96 + 64 + 4 * q; store4(dst, x1); store4(dst + 16, x2); }
            }
        }
    }
};

struct EpiMlaQ {
    const Params* pp;
    __device__ __forceinline__ void operator()(f32x4 (&acc)[4][4], int nb0, int tb0, int lane) const {
        const Params& p = *pp; const int q = lane >> 4, r16 = lane & 15;
#pragma unroll
        for (int ti = 0; ti < 4; ++ti) {
            const int t = tb0 + ti * 16 + r16; int b, j; tok_decode(t, b, j); const bool lat = j < SEQ;
            const f32x4 s4 = *(const f32x4*)(p.ssq + (size_t)t * 8);
            const float rq = frsq((s4[0] + s4[1] + s4[2] + s4[3]) * (1.f / 256.f) + EPS) * MLA_SC;
#pragma unroll
            for (int ni = 0; ni < 4; ++ni) {
                const int k16 = (nb0 >> 4) + ni, head = k16 / 6, part = k16 - head * 6;
                bf16_t* dst = p.Qm + ((size_t)(b * 4 + head) * NKEY + j) * 96 + part * 16 + 4 * q;
                if (part < 4) store4(dst, acc[ni][ti] * rq);
                else if (part == 4) { if (ni < 3) { f32x4 x1 = acc[ni][ti] * rq, x2 = acc[ni < 3 ? ni + 1 : ni][ti] * rq;
                    if (lat) rope4(x1, x2, p.cs16 + ((size_t)j * 16 + 4 * q) * 2);
                    store4(dst, x1); store4(dst + 16, x2); } }
            }
        }
    }
};
struct EpiMlaKV {
    const Params* pp;
    __device__ __forceinline__ void operator()(f32x4 (&acc)[4][4], int nb0, int tb0, int lane) const {
        const Params& p = *pp; const int q = lane >> 4, r16 = lane & 15;
        const int head = nb0 >> 7; const bool isv = (nb0 & 64) != 0;
#pragma unroll
        for (int ti = 0; ti < 4; ++ti) {
            const int t = tb0 + ti * 16 + r16; int b, j; tok_decode(t, b, j);
            const float rkv = frsq((p.ssq[(size_t)t * 8 + 4] + p.ssq[(size_t)t * 8 + 5]) * (1.f / 128.f) + EPS);
#pragma unroll
            for (int ni = 0; ni < 4; ++ni) {
                if (!isv) store4(p.Km + ((size_t)(b * 4 + head) * NKEY + j) * 96 + ni * 16 + 4 * q, acc[ni][ti] * rkv);
                else { bf16_t* base = p.VmT + (size_t)(b * 4 + head) * 64 * NKEY + j;
#pragma unroll
                    for (int e = 0; e < 4; ++e) base[(size_t)(ni * 16 + 4 * q + e) * NKEY] = (bf16_t)(pk_bf16(acc[ni][ti][e] * rkv, 0.f) & 0xffffu); }
            }
        }
    }
};
struct EpiBf16Out {
    bf16_t* O; int ldo;
    __device__ __forceinline__ void operator()(f32x4 (&acc)[4][4], int nb0, int tb0, int lane) const {
        const int q = lane >> 4, r16 = lane & 15;
#pragma unroll
        for (int ti = 0; ti < 4; ++ti) { bf16_t* row = O + (size_t)(tb0 + ti * 16 + r16) * ldo + nb0 + 4 * q;
#pragma unroll
            for (int ni = 0; ni < 4; ++ni) store4(row + ni * 16, acc[ni][ti]); }
    }
};
__device__ __forceinline__ void gemm_phase_n1024(unsigned char* lds, const bf16_t* W, int ldw, const bf16_t* A, int lda, int K, bool with_ctx, bf16_t* O) {
    EpiBf16Out e{O, DM};
    gemm_phase(lds, W, ldw, A, lda, K, NLAT / 128, 8, e);
    if (with_ctx) {
        if (gridDim.x == 512) {
            if (((blockIdx.x >> 3) & 3) == 0) { const int u = (blockIdx.x >> 5) * 8 + (blockIdx.x & 7); gemm_tile_small(lds, W, ldw, A, lda, K, (u & 7) * 128, NLAT + (u >> 3) * 32, O, DM); }
        } else for (int u = blockIdx.x; u < 128; u += gridDim.x) gemm_tile_small(lds, W, ldw, A, lda, K, (u & 7) * 128, NLAT + (u >> 3) * 32, O, DM);
    }
}
struct EpiSwiglu {
    bf16_t* G;
    __device__ __forceinline__ void operator()(f32x4 (&acc)[4][4], int nb0, int tb0, int lane) const {
        const int q = lane >> 4, r16 = lane & 15;
#pragma unroll
        for (int ti = 0; ti < 4; ++ti) { bf16_t* row = G + (size_t)(tb0 + ti * 16 + r16) * FFN + ((nb0 >> 5) * 16) + 4 * q;
#pragma unroll
            for (int mp = 0; mp < 2; ++mp) { f32x4 a;
#pragma unroll
                for (int e = 0; e < 4; ++e) { const float g = acc[2 * mp][ti][e], u = acc[2 * mp + 1][ti][e]; a[e] = g * __builtin_amdgcn_rcpf(1.f + fexp2(-g * LOG2E)) * u; }
                store4(row + mp * 16, a); } }
    }
};

template <int DQK>
__device__ __forceinline__ void attn_pipe(unsigned char* lds, const bf16_t* __restrict__ Qw, const bf16_t* __restrict__ Kh, const bf16_t* __restrict__ VTh, int kt0, int kt1, f32x16 (&O)[2], float& lfin) {
    constexpr int KMAIN = DQK >= 64 ? 8192 : 4096, KROPE = DQK == 96 ? 4096 : 0, VOFF = KMAIN + KROPE, STG = VOFF + 8192;
    constexpr int NPW = DQK == 96 ? 5 : (DQK == 64 ? 4 : 3);
    static_assert(3 * STG <= LDS_BYTES, "three stages must fit");
    const int tid = otid(), lane = tid & 63, wid = tid >> 6, h = lane >> 5, lr = lane & 31;
    const int pr = (lr & ~12) | ((lr & 4) << 1) | ((lr & 8) >> 1);
    bf16x8 qf[DQK / 16];
#pragma unroll
    for (int ks = 0; ks < DQK / 16; ++ks) qf[ks] = *(const bf16x8*)(Qw + (size_t)lr * DQK + ks * 16 + 8 * h);
#pragma unroll
    for (int r = 0; r < 16; ++r) { O[0][r] = 0.f; O[1][r] = 0.f; }
    float m = 0.f, lsum = 0.f; bool has_ref = false;
    const int n = kt1 - kt0;
    unsigned soff[NPW], doff[NPW];
    {
        const int r8 = lane >> 3, p8 = lane & 7, r4 = lane >> 2, p4 = lane & 3;
        if (DQK >= 64) {
#pragma unroll
            for (int i = 0; i < 2; ++i) { const int g = wid + 4 * i, row = 8 * g + r8; soff[i] = (unsigned)(row * DQK + (p8 ^ ((row >> 1) & 7)) * 8); doff[i] = (unsigned)(g * 1024); }
            if (DQK == 96) { const int row = 16 * wid + r4; soff[2] = (unsigned)(row * DQK + 64 + (p4 ^ ((row >> 2) & 3)) * 8); doff[2] = (unsigned)(KMAIN + wid * 1024); }
        } else { const int row = 16 * wid + r4; soff[0] = (unsigned)(row * DQK + (p4 ^ ((row >> 2) & 3)) * 8); doff[0] = (unsigned)(wid * 1024); }
#pragma unroll
        for (int i = 0; i < 2; ++i) { const int g = wid + 4 * i, row = 8 * g + r8; soff[NPW - 2 + i] = (unsigned)(row * NKEY + (p8 ^ ((row >> 1) & 7)) * 8); doff[NPW - 2 + i] = (unsigned)(VOFF + g * 1024); }
    }
    const unsigned lbase = (unsigned)(size_t)lds;
#define AP_DMA(kt_, off_) do { \
        _Pragma("unroll") for (int i = 0; i < NPW - 2; ++i) __builtin_amdgcn_global_load_lds((const unsigned*)(Kh + (size_t)(kt_) * 64 * DQK + soff[i]), (LASP unsigned*)(lbase + (unsigned)(off_) + doff[i]), 16, 0, 0); \
        _Pragma("unroll") for (int i = NPW - 2; i < NPW; ++i) __builtin_amdgcn_global_load_lds((const unsigned*)(VTh + (size_t)(kt_) * 64 + soff[i]), (LASP unsigned*)(lbase + (unsigned)(off_) + doff[i]), 16, 0, 0); } while (0)
    const int swk = (pr >> 1) & 7, swr = (pr >> 2) & 3, swv = (lr >> 1) & 7;
#define AP_KADDR(ks_) (DQK >= 64 ? ((ks_) < 4 ? pr * 128 + (((ks_) * 2 + h) ^ swk) * 16 : KMAIN + pr * 64 + ((((ks_) - 4) * 2 + h) ^ swr) * 16) : pr * 64 + (((ks_) * 2 + h) ^ swr) * 16)
#define AP_KROW32(ks_) ((DQK >= 64 && (ks_) < 4) ? 32 * 128 : 32 * 64)
#define AP_QKCHAIN(Sx0, Sx1, kb_) do { _Pragma("unroll") for (int ks = 0; ks < DQK / 16; ++ks) { \
            const bf16x8 k0_ = *(const bf16x8*)((kb_) + AP_KADDR(ks)), k1_ = *(const bf16x8*)((kb_) + AP_KADDR(ks) + AP_KROW32(ks)); \
            Sx0 = __builtin_amdgcn_mfma_f32_32x32x16_bf16(k0_, qf[ks], Sx0, 0, 0, 0); Sx1 = __builtin_amdgcn_mfma_f32_32x32x16_bf16(k1_, qf[ks], Sx1, 0, 0, 0); } } while (0)
#define AP_QK(Sx0, Sx1, off_) do { const unsigned char* kbq_ = lds + (off_); \
        if (has_ref) { const float ni_ = -m; _Pragma("unroll") for (int r = 0; r < 16; ++r) { Sx0[r] = ni_; Sx1[r] = ni_; } AP_QKCHAIN(Sx0, Sx1, kbq_); } \
        else { _Pragma("unroll") for (int r = 0; r < 16; ++r) { Sx0[r] = 0.f; Sx1[r] = 0.f; } AP_QKCHAIN(Sx0, Sx1, kbq_); } } while (0)
#define AP_BODY(t_, Sc0, Sc1, Sn0, Sn1, DMA_, NXT_) do { \
        constexpr bool nxt_ = NXT_; \
        if (DMA_) AP_DMA(kt0 + (t_) + 2, ow); \
        if (nxt_) AP_QK(Sn0, Sn1, ok); \
        bf16x8 vfr_[4]; \
        { const unsigned char* vb_ = lds + ov + VOFF + lr * 128; \
          _Pragma("unroll") for (int ksp = 0; ksp < 2; ++ksp) { const int vp_ = ((ksp * 2 + h) ^ swv) * 16; vfr_[2 * ksp] = *(const bf16x8*)(vb_ + vp_); vfr_[2 * ksp + 1] = *(const bf16x8*)(vb_ + 32 * 128 + vp_); } } \
        asm volatile("" ::: "memory");     \
        if (((t_) & 3) == 0) {   \
        const float seed_ = fmaxf(Sc0[15], Sc1[15]); \
        float mxa_ = max3f(seed_, Sc0[0], Sc0[1]), mxb_ = max3f(seed_, Sc1[0], Sc1[1]); \
        _Pragma("unroll") for (int r = 2; r < 14; r += 2) { mxa_ = max3f(mxa_, Sc0[r], Sc0[r + 1]); mxb_ = max3f(mxb_, Sc1[r], Sc1[r + 1]); } \
        float mx_ = max3f(mxa_, mxb_, Sc0[14]); mx_ = max3f(mx_, Sc1[14], mx_); mx_ = xhalf_max(mx_); \
        const bool first_ = (t_) == 0; \
        if (__any(mx_ > 40.f || (first_ && mx_ < -40.f))) { \
            const float dm_ = (mx_ > 40.f || (first_ && mx_ < -40.f)) ? mx_ : 0.f; \
            if (!first_) { const float al_ = fexp2(-dm_); lsum *= al_; _Pragma("unroll") for (int r = 0; r < 16; ++r) { O[0][r] *= al_; O[1][r] *= al_; } } \
            m += dm_; has_ref = true; \
            _Pragma("unroll") for (int r = 0; r < 16; ++r) { Sc0[r] -= dm_; Sc1[r] -= dm_; } \
            if (nxt_) { _Pragma("unroll") for (int r = 0; r < 16; ++r) { Sn0[r] -= dm_; Sn1[r] -= dm_; } } \
        } } \
        float ps_ = 0.f, pt_ = 0.f; \
        _Pragma("unroll") for (int r = 0; r < 16; ++r) { Sc0[r] = fexp2(Sc0[r]); Sc1[r] = fexp2(Sc1[r]); ps_ += Sc0[r]; pt_ += Sc1[r]; } \
        lsum += ps_ + pt_; \
        u32x4 pw_[4]; \
        _Pragma("unroll") for (int q = 0; q < 2; ++q) { const int o = q * 8; \
            pw_[q].x = pk_bf16(Sc0[o], Sc0[o + 1]); pw_[q].y = pk_bf16(Sc0[o + 2], Sc0[o + 3]); pw_[q].z = pk_bf16(Sc0[o + 4], Sc0[o + 5]); pw_[q].w = pk_bf16(Sc0[o + 6], Sc0[o + 7]); \
            pw_[2 + q].x = pk_bf16(Sc1[o], Sc1[o + 1]); pw_[2 + q].y = pk_bf16(Sc1[o + 2], Sc1[o + 3]); pw_[2 + q].z = pk_bf16(Sc1[o + 4], Sc1[o + 5]); pw_[2 + q].w = pk_bf16(Sc1[o + 6], Sc1[o + 7]); } \
        { const unsigned char* vb_ = lds + ov + VOFF + lr * 128; \
          _Pragma("unroll") for (int ksp = 0; ksp < 4; ++ksp) { const int vp_ = ((ksp * 2 + h) ^ swv) * 16; \
              const bf16x8 v0_ = ksp < 2 ? vfr_[2 * (ksp & 1)] : *(const bf16x8*)(vb_ + vp_), v1_ = ksp < 2 ? vfr_[2 * (ksp & 1) + 1] : *(const bf16x8*)(vb_ + 32 * 128 + vp_); const bf16x8 pc_ = __builtin_bit_cast(bf16x8, pw_[ksp]); \
              O[0] = __builtin_amdgcn_mfma_f32_32x32x16_bf16(v0_, pc_, O[0], 0, 0, 0); O[1] = __builtin_amdgcn_mfma_f32_32x32x16_bf16(v1_, pc_, O[1], 0, 0, 0); } } \
        asm volatile("s_waitcnt vmcnt(0)" ::: "memory");     \
        __syncthreads(); \
        { const int tmp_ = ov; ov = ok; ok = ow; ow = tmp_; } } while (0)
    int ov = 0, ok = STG, ow = 2 * STG;
    f32x16 Sa0, Sa1, Sb0, Sb1;
    AP_DMA(kt0, 0); AP_DMA(kt0 + 1, STG);
    asm volatile("s_waitcnt vmcnt(0)" ::: "memory");
    __syncthreads();
    AP_QK(Sa0, Sa1, 0);
    int t = 0;
    for (; t < n - 2; t += 2) {
        AP_BODY(t, Sa0, Sa1, Sb0, Sb1, true, true);
        AP_BODY(t + 1, Sb0, Sb1, Sa0, Sa1, true, true);
    }
    AP_BODY(t, Sa0, Sa1, Sb0, Sb1, false, true);
    AP_BODY(t + 1, Sb0, Sb1, Sa0, Sa1, false, false);
#undef AP_DMA
#undef AP_KADDR
#undef AP_KROW32
#undef AP_QKCHAIN
#undef AP_QK
#undef AP_BODY
    lfin = xhalf_sum(lsum);
}

__device__ __forceinline__ void attn_gqa2(unsigned char* lds, const bf16_t* __restrict__ Qw, const bf16_t* __restrict__ Kh, const bf16_t* __restrict__ VTh, int kt0, int kt1, f32x16 (&O)[2][2], float (&lfin)[2]) {
    constexpr int DQK = 64, VOFF = 8192, STG = 16384;
    const int tid = otid(), lane = tid & 63, wid = tid >> 6, h = lane >> 5, lr = lane & 31;
    const int pr = (lr & ~12) | ((lr & 4) << 1) | ((lr & 8) >> 1);
    bf16x8 qf[2][4];
#pragma unroll
    for (int c = 0; c < 2; ++c)
#pragma unroll
        for (int ks = 0; ks < 4; ++ks) qf[c][ks] = *(const bf16x8*)(Qw + (size_t)(c * 32 + lr) * DQK + ks * 16 + 8 * h);
#pragma unroll
    for (int c = 0; c < 2; ++c)
#pragma unroll
        for (int r = 0; r < 16; ++r) { O[c][0][r] = 0.f; O[c][1][r] = 0.f; }
    float m[2] = {0.f, 0.f}, lsum[2] = {0.f, 0.f}; bool has_ref = false;
    const int n = kt1 - kt0;
    unsigned soff[4], doff[4];
    { const int r8 = lane >> 3, p8 = lane & 7;
#pragma unroll
      for (int i = 0; i < 2; ++i) { const int g = wid + 4 * i, row = 8 * g + r8, c = p8 ^ ((row >> 1) & 7);
          soff[i] = (unsigned)(row * DQK + c * 8); doff[i] = (unsigned)(g * 1024); soff[2 + i] = (unsigned)(row * NKEY + c * 8); doff[2 + i] = (unsigned)(VOFF + g * 1024); } }
    const unsigned lbase = (unsigned)(size_t)lds;
#define G2_DMA(kt_, off_) do { \
        _Pragma("unroll") for (int i = 0; i < 2; ++i) __builtin_amdgcn_global_load_lds((const unsigned*)(Kh + (size_t)(kt_) * 64 * DQK + soff[i]), (LASP unsigned*)(lbase + (unsigned)(off_) + doff[i]), 16, 0, 0); \
        _Pragma("unroll") for (int i = 2; i < 4; ++i) __builtin_amdgcn_global_load_lds((const unsigned*)(VTh + (size_t)(kt_) * 64 + soff[i]), (LASP unsigned*)(lbase + (unsigned)(off_) + doff[i]), 16, 0, 0); } while (0)
    const int swk = (pr >> 1) & 7, swv = (lr >> 1) & 7;
    G2_DMA(kt0, 0);
    asm volatile("s_waitcnt vmcnt(0)" ::: "memory");
    __syncthreads();
    for (int t = 0; t < n; ++t) {
        const int so = (t & 1) * STG;
        if (t + 1 < n) G2_DMA(kt0 + t + 1, STG - so);
        const bool chk = (t & 3) == 0, first = t == 0;
        u32x4 pw[2][4];
        f32x16 S[2][2];
#define G2_QK2() do { const unsigned char* kb = lds + so + pr * 128; _Pragma("unroll") for (int ks = 0; ks < 4; ++ks) { const int kp = ((ks * 2 + h) ^ swk) * 16; \
            const bf16x8 k0 = *(const bf16x8*)(kb + kp), k1 = *(const bf16x8*)(kb + 32 * 128 + kp); \
            S[0][0] = __builtin_amdgcn_mfma_f32_32x32x16_bf16(k0, qf[0][ks], S[0][0], 0, 0, 0); S[0][1] = __builtin_amdgcn_mfma_f32_32x32x16_bf16(k1, qf[0][ks], S[0][1], 0, 0, 0); \
            S[1][0] = __builtin_amdgcn_mfma_f32_32x32x16_bf16(k0, qf[1][ks], S[1][0], 0, 0, 0); S[1][1] = __builtin_amdgcn_mfma_f32_32x32x16_bf16(k1, qf[1][ks], S[1][1], 0, 0, 0); } } while (0)
        if (has_ref) {
#pragma unroll
            for (int c = 0; c < 2; ++c) { const float ni = -m[c];
#pragma unroll
                for (int r = 0; r < 16; ++r) { S[c][0][r] = ni; S[c][1][r] = ni; } }
            G2_QK2();
        } else {
#pragma unroll
            for (int c = 0; c < 2; ++c)
#pragma unroll
                for (int r = 0; r < 16; ++r) { S[c][0][r] = 0.f; S[c][1][r] = 0.f; }
            G2_QK2();
        }
#undef G2_QK2
        __builtin_amdgcn_sched_barrier(0);
        bf16x8 vf[8];
#pragma unroll
        for (int c = 0; c < 2; ++c) {
            if (chk) {
                const float seed = fmaxf(S[c][0][15], S[c][1][15]);
                float mxa = max3f(seed, S[c][0][0], S[c][0][1]), mxb = max3f(seed, S[c][1][0], S[c][1][1]);
#pragma unroll
                for (int r = 2; r < 14; r += 2) { mxa = max3f(mxa, S[c][0][r], S[c][0][r + 1]); mxb = max3f(mxb, S[c][1][r], S[c][1][r + 1]); }
                float mx = max3f(mxa, mxb, S[c][0][14]); mx = max3f(mx, S[c][1][14], mx);
                if (__any(first || mx > 40.f)) {
                    const float mq = xhalf_max(mx);
                    const float dm = (mq > 40.f || (first && mq < -40.f)) ? mq : 0.f;
                    if (!first) { const float al = fexp2(-dm); lsum[c] *= al;
#pragma unroll
                        for (int r = 0; r < 16; ++r) { O[c][0][r] *= al; O[c][1][r] *= al; } }
                    m[c] += dm; has_ref = true;
#pragma unroll
                    for (int r = 0; r < 16; ++r) { S[c][0][r] -= dm; S[c][1][r] -= dm; }
                }
            }
            float ps = 0.f, pt = 0.f;
#pragma unroll
            for (int r = 0; r < 16; ++r) { S[c][0][r] = fexp2(S[c][0][r]); S[c][1][r] = fexp2(S[c][1][r]); ps += S[c][0][r]; pt += S[c][1][r]; }
            lsum[c] += ps + pt;
#pragma unroll
            for (int q2 = 0; q2 < 2; ++q2) { const int o = q2 * 8;
                pw[c][q2].x = pk_bf16(S[c][0][o], S[c][0][o + 1]); pw[c][q2].y = pk_bf16(S[c][0][o + 2], S[c][0][o + 3]); pw[c][q2].z = pk_bf16(S[c][0][o + 4], S[c][0][o + 5]); pw[c][q2].w = pk_bf16(S[c][0][o + 6], S[c][0][o + 7]);
                pw[c][2 + q2].x = pk_bf16(S[c][1][o], S[c][1][o + 1]); pw[c][2 + q2].y = pk_bf16(S[c][1][o + 2], S[c][1][o + 3]); pw[c][2 + q2].z = pk_bf16(S[c][1][o + 4], S[c][1][o + 5]); pw[c][2 + q2].w = pk_bf16(S[c][1][o + 6], S[c][1][o + 7]); }
            __builtin_amdgcn_sched_barrier(0);
            if (c == 0) { const unsigned char* vb = lds + so + VOFF + lr * 128;
#pragma unroll
                for (int ksp = 0; ksp < 4; ++ksp) { const int vp = ((ksp * 2 + h) ^ swv) * 16; vf[2 * ksp] = *(const bf16x8*)(vb + vp); vf[2 * ksp + 1] = *(const bf16x8*)(vb + 32 * 128 + vp); }
                __builtin_amdgcn_sched_barrier(0); }
        }
        {
#pragma unroll
          for (int ksp = 0; ksp < 4; ++ksp) {
              const bf16x8 v0 = vf[2 * ksp], v1 = vf[2 * ksp + 1];
              const bf16x8 p0 = __builtin_bit_cast(bf16x8, pw[0][ksp]), p1 = __builtin_bit_cast(bf16x8, pw[1][ksp]);
              O[0][0] = __builtin_amdgcn_mfma_f32_32x32x16_bf16(v0, p0, O[0][0], 0, 0, 0); O[0][1] = __builtin_amdgcn_mfma_f32_32x32x16_bf16(v1, p0, O[0][1], 0, 0, 0);
              O[1][0] = __builtin_amdgcn_mfma_f32_32x32x16_bf16(v0, p1, O[1][0], 0, 0, 0); O[1][1] = __builtin_amdgcn_mfma_f32_32x32x16_bf16(v1, p1, O[1][1], 0, 0, 0); } }
        asm volatile("s_waitcnt vmcnt(0)" ::: "memory");
        __syncthreads();
    }
#undef G2_DMA
    lfin[0] = xhalf_sum(lsum[0]); lfin[1] = xhalf_sum(lsum[1]);
}

__device__ __forceinline__ void store_o(bf16_t* yrow  , const f32x16 (&O)[2], int h) {
#pragma unroll
    for (int mb = 0; mb < 2; ++mb)
#pragma unroll
        for (int q4 = 0; q4 < 4; ++q4) { u32x2 w; w.x = pk_bf16(O[mb][q4 * 4], O[mb][q4 * 4 + 1]); w.y = pk_bf16(O[mb][q4 * 4 + 2], O[mb][q4 * 4 + 3]); *(u32x2*)(yrow + mb * 32 + q4 * 8 + 4 * h) = w; }
}

__device__ __forceinline__ int tok_row(int b, int qrow) { return qrow < SEQ ? b * SEQ + qrow : NLAT + b * CTXL + (qrow - SEQ); }
__device__ __forceinline__ void attn_unit(unsigned char* lds, const Params& p, int l, int type, int b, int head, int qb) {
    const int tid = otid(), lane = tid & 63, wid = tid >> 6, h = lane >> 5, lr = lane & 31;
    const int kt0 = qb < 64 ? 0 : 128, kt1 = 132;
    const int qrow0 = qb * 128 + wid * 32;
    bf16_t* y = p.hbuf + (size_t)tok_row(b, qrow0 + lr) * DM;
    f32x16 O[2]; float lf;
    if (type == 0) {
        const size_t hb = (size_t)(b * 4 + head);
        attn_pipe<96>(lds, p.Qm + (hb * NKEY + qrow0) * 96, p.Km + hb * NKEY * 96, p.VmT + hb * 64 * NKEY, kt0, kt1, O, lf);
        const float inv = 1.f / lf;
#pragma unroll
        for (int r = 0; r < 16; ++r) { O[0][r] *= inv; O[1][r] *= inv; }
        store_o(y + head * 64, O, h);
    } else if (type == 2) {
        const int kt0g = qb < 32 ? 0 : 128, qrow0g = qb * 256 + wid * 64;
        const size_t hq = (size_t)(b * 8 + head), hk = (size_t)(b * 2 + (head >> 2));
        f32x16 O2[2][2]; float lf2[2];
        attn_gqa2(lds, p.Qg + (hq * NKEY + qrow0g) * 64, p.Kg + hk * NKEY * 64, p.VgT + hk * 64 * NKEY, kt0g, kt1, O2, lf2);
#pragma unroll
        for (int c = 0; c < 2; ++c) { const float inv = 1.f / lf2[c];
#pragma unroll
            for (int r = 0; r < 16; ++r) { O2[c][0][r] *= inv; O2[c][1][r] *= inv; }
            store_o(p.hbuf + (size_t)tok_row(b, qrow0g + c * 32 + lr) * DM + 512 + head * 64, O2[c], h); }
    } else {
        f32x16 O1[2];
        const size_t m0 = (size_t)(b * 8 + 2 * head) * NKEY, m1 = m0 + NKEY;
        attn_pipe<32>(lds, p.Qd + (m0 + qrow0) * 32, p.Kd + m0 * 32, p.VdT + (size_t)(b * 4 + head) * 64 * NKEY, kt0, kt1, O1, lf);
        const float inv1 = 1.f / lf;
#pragma unroll
        for (int r = 0; r < 16; ++r) { O1[0][r] *= inv1; O1[1][r] *= inv1; }
        attn_pipe<32>(lds, p.Qd + (m1 + qrow0) * 32, p.Kd + m1 * 32, p.VdT + (size_t)(b * 4 + head) * 64 * NKEY, kt0, kt1, O, lf);
        const float inv2 = p.lam[l] / lf;
        float ss = 0.f;
#pragma unroll
        for (int r = 0; r < 16; ++r) { O[0][r] = O1[0][r] - inv2 * O[0][r]; O[1][r] = O1[1][r] - inv2 * O[1][r]; ss += O[0][r] * O[0][r] + O[1][r] * O[1][r]; }
        ss = xhalf_sum(ss);
        const float lam_init = 0.8f - 0.6f * __expf(-0.3f * (float)l);
        const float rinv = frsq(ss * (1.f / 64.f) + EPS) * (1.f - lam_init);
        const float* g = p.g_diff_sub + l * 64;
#pragma unroll
        for (int mb = 0; mb < 2; ++mb)
#pragma unroll
            for (int q4 = 0; q4 < 4; ++q4) { const f32x4 gv = *(const f32x4*)(g + mb * 32 + q4 * 8 + 4 * h);
#pragma unroll
                for (int e = 0; e < 4; ++e) O[mb][q4 * 4 + e] *= rinv * gv[e]; }
        store_o(y + 256 + head * 64, O, h);
    }
}

__device__ __forceinline__ void attn_phase(unsigned char* lds, const Params& p, int l) {
    __shared__ int s_unit;
    const int qlen = 192 + (l == 0 ? 6 : 0);
    const int xcc = (int)(__builtin_amdgcn_s_getreg((3 << 11) | 20) & 7u);
    for (int xo = 0; xo < 8; ++xo) {
        const int q = (xcc + xo) & 7;
        unsigned* ctr = p.counters + l * 8 + q;
        for (;;) {
            if (otid() == 0) s_unit = (int)atomicAdd(ctr, 1u);
            __syncthreads();
            const int i = s_unit;
            __syncthreads();
            if (i >= qlen) break;
            int type, b, head, qb;
            if (i < 64) { type = 2; b = q >> 2; head = ((q >> 1) & 1) * 4 + (q & 1) * 2 + (i >> 5); qb = i & 31; }
            else if (i < 128) { type = 1; b = q >> 2; head = q & 3; qb = i - 64; }
            else if (i < 192) { type = 0; b = q >> 2; head = q & 3; qb = i - 128; }
            else { const int j = q * 6 + (i - 192);
                if (j < 16) { type = 2; b = j >> 3; head = j & 7; qb = 32; } else if (j < 32) { const int w = j - 16; type = 1; b = w >> 3; head = (w >> 1) & 3; qb = 64 + (w & 1); }
                else { const int w = j - 32; type = 0; b = w >> 3; head = (w >> 1) & 3; qb = 64 + (w & 1); } }
            attn_unit(lds, p, l, type, b, head, qb);
        }
    }
}

__device__ __forceinline__ void norm_store(const f32x4 (&v)[4], float ss, const float* g, const float* sc, const float* sh, bf16_t* hrow, int lane) {
    const float r = frsq(ss * (1.f / 1024.f) + EPS);
#pragma unroll
    for (int i = 0; i < 4; ++i) { const int c = i * 256 + lane * 4; const f32x4 gg = *(const f32x4*)(g + c), s1 = *(const f32x4*)(sc + c), s0 = *(const f32x4*)(sh + c);
        float o[4];
#pragma unroll
        for (int e = 0; e < 4; ++e) o[e] = v[i][e] * r * gg[e] * (1.f + s1[e]) + s0[e];
        u32x2 w; w.x = pk_bf16(o[0], o[1]); w.y = pk_bf16(o[2], o[3]); *(u32x2*)(hrow + c) = w; }
}
__device__ __forceinline__ void phase_prenorm0(const Params& p) {
    const int tid = otid(), lane = tid & 63, gw = blockIdx.x * 4 + (tid >> 6), nw = gridDim.x * 4;
    for (int row = gw; row < NT; row += nw) {
        const float* xr = xin_row(p, 0, row); f32x4 v[4]; float ss = 0.f;
#pragma unroll
        for (int i = 0; i < 4; ++i) { v[i] = *(const f32x4*)(xr + i * 256 + lane * 4); ss += v[i][0] * v[i][0] + v[i][1] * v[i][1] + v[i][2] * v[i][2] + v[i][3] * v[i][3]; }
        ss = wave_sum(ss);
        const float* m = p.mod + (size_t)mod_vec(row) * 6144;
        norm_store(v, ss, p.g_attn_pre, m + 1024, m, p.hbuf + (size_t)row * DM, lane);
    }
}
__device__ __forceinline__ void phase_rowupdate(const Params& p, int l, int which) {
    const int tid = otid(), lane = tid & 63, gw = blockIdx.x * 4 + (tid >> 6), nw = gridDim.x * 4;
    const bool last = l == DEPTH - 1; const int nrows = last ? NLAT : NT;
    for (int row = gw; row < nrows; row += nw) {
        const bf16_t* yr = (const bf16_t*)p.Yf + (size_t)row * DM; const float* xo = which == 0 ? xin_row(p, l, row) : xw_row(p, row); float* xn = xw_row(p, row);
        const float* m = p.mod + (size_t)(l * 3 + mod_vec(row)) * 6144;
        const float* gate = m + (which == 0 ? 2048 : 5120); const float* gp = (which == 0 ? p.g_attn_post : p.g_ffn_post) + l * DM;
        f32x4 y[4], x[4]; float ss = 0.f;
#pragma unroll
        for (int i = 0; i < 4; ++i) { const u32x2 yb = *(const u32x2*)(yr + i * 256 + lane * 4); y[i] = (f32x4){__uint_as_float(yb.x << 16), __uint_as_float(yb.x & 0xffff0000u), __uint_as_float(yb.y << 16), __uint_as_float(yb.y & 0xffff0000u)}; x[i] = *(const f32x4*)(xo + i * 256 + lane * 4); ss += y[i][0] * y[i][0] + y[i][1] * y[i][1] + y[i][2] * y[i][2] + y[i][3] * y[i][3]; }
        ss = wave_sum(ss);
        const float r = frsq(ss * (1.f / 1024.f) + EPS); float s2 = 0.f;
#pragma unroll
        for (int i = 0; i < 4; ++i) { const int c = i * 256 + lane * 4; const f32x4 gt = *(const f32x4*)(gate + c), gg = *(const f32x4*)(gp + c);
#pragma unroll
            for (int e = 0; e < 4; ++e) { x[i][e] += gt[e] * (y[i][e] * r * gg[e]); s2 += x[i][e] * x[i][e]; }
            *(f32x4*)(xn + c) = x[i]; }
        if (which == 0) { s2 = wave_sum(s2); norm_store(x, s2, p.g_ffn_pre + l * DM, m + 4096, m + 3072, p.hbuf + (size_t)row * DM, lane); }
        else if (!last) { s2 = wave_sum(s2); const float* m2 = p.mod + (size_t)((l + 1) * 3 + mod_vec(row)) * 6144; norm_store(x, s2, p.g_attn_pre + (l + 1) * DM, m2 + 1024, m2, p.hbuf + (size_t)row * DM, lane); }
    }
}

__device__ __forceinline__ void conv_tile(unsigned char* lds, const float* __restrict__ src, int K, int N, int kt, int nt, bf16_t* dst, int mode, const float* kscale) {
    float* tile = (float*)lds;
    const int tid = otid(), k0 = kt * 64, n0 = nt * 64;
#pragma unroll 4
    for (int i = 0; i < 16; ++i) { const int k = i * 4 + (tid >> 6), n = tid & 63; float v = 0.f; if (n0 + n < N) { v = src[(size_t)(k0 + k) * N + n0 + n]; if (kscale) v *= kscale[k0 + k]; } tile[k * 65 + n] = v; }
    __syncthreads();
#pragma unroll
    for (int jj = 0; jj < 2; ++jj) { const int c = tid + 256 * jj, n = c >> 3, kc = c & 7, ng = n0 + n;
        if (ng < N) { int row;
            if (mode == 1) row = ng < 384 ? ng : (ng < 416 ? ng + 1536 : ng - 32);
            else if (mode == 2) row = 32 * (ng >> 4) + (ng & 15);
            else if (mode == 3) row = 32 * (ng >> 4) + 16 + (ng & 15);
            else row = ng;
            float e[8];
#pragma unroll
            for (int q = 0; q < 8; ++q) e[q] = tile[(kc * 8 + q) * 65 + n];
            u32x4 w; w.x = pk_bf16(e[0], e[1]); w.y = pk_bf16(e[2], e[3]); w.z = pk_bf16(e[4], e[5]); w.w = pk_bf16(e[6], e[7]);
            *(u32x4*)(dst + (size_t)row * K + k0 + kc * 8) = w; } }
    __syncthreads();
}
__device__ __forceinline__ void sincos_d(double x, float& s, float& c) {
    const double n = rint(x * 0.63661977236758134308);
    double r = x - n * 1.57079632679489655800; r -= n * 6.12323399573676603587e-17;
    const double r2 = r * r;
    double sp = r * (1.0 + r2 * (-1.0 / 6 + r2 * (1.0 / 120 + r2 * (-1.0 / 5040 + r2 * (1.0 / 362880 + r2 * (-1.0 / 39916800 + r2 * (1.0 / 6227020800.0)))))));
    double cp = 1.0 + r2 * (-0.5 + r2 * (1.0 / 24 + r2 * (-1.0 / 720 + r2 * (1.0 / 40320 + r2 * (-1.0 / 3628800 + r2 * (1.0 / 479001600.0))))));
    const int q = ((int)n) & 3;
    const double ss = (q == 0) ? sp : (q == 1) ? cp : (q == 2) ? -sp : -cp;
    const double cc = (q == 0) ? cp : (q == 1) ? -sp : (q == 2) ? -cp : sp;
    s = (float)ss; c = (float)cc;
}
constexpr int CONV_PER_LAYER = 2904, N_CONV = 2 * CONV_PER_LAYER, N_ADA = 192, N_ROPE = 1536, N_PAD = 2;
__device__ __forceinline__ void phase_prologue(unsigned char* lds, const Params& p) {
    const int tid = otid();
    const int total = N_CONV + N_ADA + N_ROPE + N_PAD;
    for (int u = blockIdx.x; u < total; u += gridDim.x) {
        if (u < N_ADA) {
            const int wu = u * 4 + (tid >> 6), lane = tid & 63, l = wu / 384, rem = wu - l * 384, cc = rem >> 4, kc = rem & 15;
            const int col = cc * 256 + lane * 4; f32x4 a0 = {0, 0, 0, 0}, a1 = a0, a2 = a0;
            const float* wbase = p.w_ada + ((size_t)l * 1024 + kc * 64) * 6144 + col;
#pragma unroll 8
            for (int k = 0; k < 64; ++k) { const int kk = kc * 64 + k; const f32x4 w = *(const f32x4*)(wbase + (size_t)k * 6144);
                const float c0 = p.c[kk], c1 = p.c[1024 + kk], c2 = p.c_ctx[kk];
                const float s0 = c0 / (1.f + __expf(-c0)), s1 = c1 / (1.f + __expf(-c1)), s2 = c2 / (1.f + __expf(-c2));
                a0 += w * s0; a1 += w * s1; a2 += w * s2; }
            float* o = p.adapart + ((size_t)(l * 16 + kc) * 3) * 6144 + col;
            *(f32x4*)o = a0; *(f32x4*)(o + 6144) = a1; *(f32x4*)(o + 2 * 6144) = a2;
        } else if (u < N_ADA + N_CONV) {
            const int v = u - N_ADA, l = v / CONV_PER_LAYER, ti = v - l * CONV_PER_LAYER;
            if (ti < 496) conv_tile(lds, p.w_in + (size_t)l * 1024 * 1952, 1024, 1952, ti / 31, ti % 31, p.wt_in + (size_t)l * INW * 1024, 1, nullptr);
            else if (ti < 520) { const int q = ti - 496; conv_tile(lds, p.w_mla_qb + (size_t)l * 256 * 384, 256, 384, q / 6, q % 6, p.wt_qb + (size_t)l * 384 * 256, 0, p.g_mla_q + l * 256); }
            else if (ti < 536) { const int q = ti - 520; conv_tile(lds, p.w_mla_kvb + (size_t)l * 128 * 512, 128, 512, q / 8, q % 8, p.wt_kvb + (size_t)l * 512 * 128, 0, p.g_mla_kv + l * 128); }
            else if (ti < 792) { const int q = ti - 536; conv_tile(lds, p.w_out + (size_t)l * 1024 * 1024, 1024, 1024, q / 16, q % 16, p.wt_out + (size_t)l * 1024 * 1024, 0, nullptr); }
            else if (ti < 1496) { const int q = ti - 792; conv_tile(lds, p.w_gate + (size_t)l * 1024 * FFN, 1024, FFN, q / 44, q % 44, p.wt_gu + (size_t)l * 2 * FFN * 1024, 2, nullptr); }
            else if (ti < 2200) { const int q = ti - 1496; conv_tile(lds, p.w_up + (size_t)l * 1024 * FFN, 1024, FFN, q / 44, q % 44, p.wt_gu + (size_t)l * 2 * FFN * 1024, 3, nullptr); }
            else { const int q = ti - 2200; conv_tile(lds, p.w_down + (size_t)l * FFN * 1024, FFN, 1024, q / 16, q % 16, p.wt_down + (size_t)l * 1024 * FFN, 0, nullptr); }
        } else if (u < N_ADA + N_CONV + N_ROPE) {
            const int e = (u - N_ADA - N_CONV) * 256 + tid, pos = e / 48, a = e - pos * 48;
            const int row = pos >> 6, col = pos & 63;
            if (a < 16) { const float inv = exp2f(-(float)(a & 7) * (13.287712379549449f / 8.f)); const float ang = (float)(a < 8 ? row : col) * inv; float s, c; sincos_d((double)ang, s, c); p.cs16[((size_t)pos * 16 + a) * 2] = c; p.cs16[((size_t)pos * 16 + a) * 2 + 1] = s; }
            else { const int a2 = a - 16; const float inv = exp2f(-(float)(a2 & 15) * (13.287712379549449f / 16.f)); const float ang = (float)(a2 < 16 ? row : col) * inv; float s, c; sincos_d((double)ang, s, c); p.cs32[((size_t)pos * 32 + a2) * 2] = c; p.cs32[((size_t)pos * 32 + a2) * 2 + 1] = s; }
        } else {
            const int l = u - (N_ADA + N_CONV + N_ROPE); u32x4 z = {0, 0, 0, 0}; u32x4* d = (u32x4*)(p.wt_in + ((size_t)l * INW + 1952) * 1024);
            for (int i = tid; i < 96 * 1024 / 8; i += NTHREADS) d[i] = z;
        }
    }
}
__device__ __forceinline__ void phase_adareduce(const Params& p) {
    const int gt = blockIdx.x * NTHREADS + otid(), ntot = gridDim.x * NTHREADS;
    for (int i = gt; i < DEPTH * 3 * 6144; i += ntot) { const int l = i / (3 * 6144), r = i - l * 3 * 6144, v = r / 6144, col = r - v * 6144;
        float s = p.b_ada[l * 6144 + col];
#pragma unroll
        for (int kc = 0; kc < 16; ++kc) s += p.adapart[((size_t)(l * 16 + kc) * 3 + v) * 6144 + col];
        p.mod[i] = s; }
    if (gt < DEPTH) { const int l = gt; float a = 0.f, b = 0.f;
        for (int i = 0; i < 32; ++i) { a += p.lq1[l * 32 + i] * p.lk1[l * 32 + i]; b += p.lq2[l * 32 + i] * p.lk2[l * 32 + i]; }
        p.lam[l] = expf(a) - expf(b) + (0.8f - 0.6f * expf(-0.3f * (float)l)); }
}

#define XB_TMO      128
#define XB_XCNT(j)  (256  + 64 * (j))
#define XB_XSUB(j)  (1280 + 64 * (j))
#define XB_XGEN(j)  (2304 + 64 * (j))
#define XB_TOP      3328
#define XB_TOPGEN   3392
#define XCD_BAR_WORDS 3456
#define XB_SPIN_CAP (1u << 22)
#define LAS __attribute__((address_space(3)))
__device__ __forceinline__ unsigned xb_ld(unsigned* p)              { return __hip_atomic_load(p, __ATOMIC_RELAXED, __HIP_MEMORY_SCOPE_AGENT); }
__device__ __forceinline__ unsigned xb_add(unsigned* p, unsigned v) { return __hip_atomic_fetch_add(p, v, __ATOMIC_RELAXED, __HIP_MEMORY_SCOPE_AGENT); }
__device__ __forceinline__ unsigned xb_xcc_id() { return (unsigned)__builtin_amdgcn_s_getreg((3 << 11) | 20) & 0xFu; }
#define XB_SPIN(cond, bar) do { unsigned _sp = 0; while (cond) { __builtin_amdgcn_s_sleep(1); \
    if ((++_sp & 255u) == 0u) { if (xb_ld(&(bar)[XB_TMO])) break; if (_sp > XB_SPIN_CAP) { atomicAdd(&(bar)[XB_TMO], 1u); break; } } } } while (0)
struct XcdBarrier { unsigned* bar; unsigned x; volatile LAS unsigned* st; };
__device__ __forceinline__ XcdBarrier xcd_barrier_post(unsigned* bar, volatile LAS unsigned* st) {
    XcdBarrier b; b.bar = bar; b.x = xb_xcc_id(); b.st = st;
    if (threadIdx.x == 0) (void)xb_add(&bar[XB_XCNT(b.x)], 1u);
    return b;
}
__device__ __forceinline__ void xcd_barrier_complete(unsigned* bar, unsigned x, unsigned& nloc, unsigned& nx) {
    const unsigned G = gridDim.x * gridDim.y * gridDim.z;
    unsigned sum, cnt, mine, sp = 0u;
    for (;;) {
        sum = 0u; cnt = 0u; mine = 0u;
#pragma unroll
        for (unsigned j = 0; j < 16; ++j) { const unsigned c = xb_ld(&bar[XB_XCNT(j)]); sum += c; cnt += (c > 0u) ? 1u : 0u; mine = (j == x) ? c : mine; }
        if (sum == G) break;
        __builtin_amdgcn_s_sleep(1);
        if ((++sp & 255u) == 0u) { if (xb_ld(&bar[XB_TMO])) break; if (sp > XB_SPIN_CAP) { atomicAdd(&bar[XB_TMO], 1u); break; } }
    }
    nloc = mine > 0u ? mine : 1u; nx = cnt > 0u ? cnt : 1u;
}
__device__ __forceinline__ void xcd_barrier(const XcdBarrier& b) {
    asm volatile("s_waitcnt vmcnt(0)" ::: "memory");
    __syncthreads();
    if (threadIdx.x == 0) {
        unsigned* bar = b.bar;
        __builtin_amdgcn_s_waitcnt(0);
        unsigned nloc = b.st[0], nx = b.st[1];
        if (nloc == 0u) { xcd_barrier_complete(bar, b.x, nloc, nx); b.st[0] = nloc; b.st[1] = nx; }
        const unsigned old = xb_add(&bar[XB_XSUB(b.x)], 1u);
        const unsigned gen = old / nloc;
        if (old + 1u == (gen + 1u) * nloc) {
            __builtin_amdgcn_fence(__ATOMIC_RELEASE, "agent");
            asm volatile("s_waitcnt vmcnt(0)" ::: "memory");
            const unsigned og = xb_add(&bar[XB_TOP], 1u);
            const unsigned tg = og / nx;
            if (og + 1u == (tg + 1u) * nx) xb_add(&bar[XB_TOPGEN], 1u);
            else XB_SPIN(xb_ld(&bar[XB_TOPGEN]) == tg, bar);
            __builtin_amdgcn_fence(__ATOMIC_ACQUIRE, "agent");
            xb_add(&bar[XB_XGEN(b.x)], 1u);
            asm volatile("s_waitcnt vmcnt(0)" ::: "memory");
        } else {
            XB_SPIN(xb_ld(&bar[XB_XGEN(b.x)]) == gen, bar);
            __builtin_amdgcn_fence(__ATOMIC_ACQUIRE, "agent");
            asm volatile("s_waitcnt vmcnt(0)" ::: "memory");
        }
    }
    __syncthreads();
}

__device__ __forceinline__ void simple_barrier(unsigned* cnt, unsigned target) {
    asm volatile("s_waitcnt vmcnt(0)" ::: "memory");
    __syncthreads();
    if (threadIdx.x == 0) {
        __builtin_amdgcn_fence(__ATOMIC_RELEASE, "agent");
        asm volatile("s_waitcnt vmcnt(0)" ::: "memory");
        (void)__hip_atomic_fetch_add(cnt, 1u, __ATOMIC_RELAXED, __HIP_MEMORY_SCOPE_AGENT);
        unsigned sp = 0;
        while (__hip_atomic_load(cnt, __ATOMIC_RELAXED, __HIP_MEMORY_SCOPE_AGENT) < target) { __builtin_amdgcn_s_sleep(2); if (++sp > (1u << 24)) break; }
        __builtin_amdgcn_fence(__ATOMIC_ACQUIRE, "agent");
        asm volatile("s_waitcnt vmcnt(0)" ::: "memory");
    }
    __syncthreads();
}

constexpr int N_PHASES = 3 + 8 * DEPTH;
__global__ void __launch_bounds__(NTHREADS, 2) fwd_kernel(Params p) {
    extern __shared__ __attribute__((aligned(16))) unsigned char lds[];
    __shared__ uint4 xb_words;
    if (threadIdx.x == 0) xb_words = make_uint4(0u, 0u, 0u, 0u);
    __syncthreads();
    XcdBarrier xb = xcd_barrier_post(p.counters + 64, (volatile LAS unsigned*)&xb_words);
    for (int ph = p.phase_begin; ph < p.phase_end; ++ph) {
        if (ph == 0) phase_prologue(lds, p);
        else if (ph == 1) phase_adareduce(p);
        else if (ph == 2) phase_prenorm0(p);
        else {
            const int l = (ph - 3) >> 3, s = (ph - 3) & 7; const bool last = l == DEPTH - 1;
            if (s == 0) { EpiInProj e{&p, l}; gemm_phase(lds, p.wt_in + (size_t)l * INW * 1024, 1024, p.hbuf, DM, 1024, NT / 128, INW / 128, e); }
            else if (s == 1) {
                EpiMlaQ eq{&p}; EpiMlaKV ek{&p};
                const int nq = 136 * 3, nkv = 136 * 4;
                for (int u = blockIdx.x; u < nq + nkv; u += gridDim.x) { int tt, nt;
                    if (u < nq) { if (gemm_unit(u, NT / 128, 3, tt, nt)) gemm_tile(lds, p.wt_qb + (size_t)l * 384 * 256, 256, p.qkva, 384, 256, nt * 128, tt * 128, eq); }
                    else { if (gemm_unit(u - nq, NT / 128, 4, tt, nt)) gemm_tile(lds, p.wt_kvb + (size_t)l * 512 * 128, 128, p.qkva + 256, 384, 128, nt * 128, tt * 128, ek); } }
            }
            else if (s == 2) attn_phase(lds, p, l);
            else if (s == 3) gemm_phase_n1024(lds, p.wt_out + (size_t)l * 1024 * 1024, 1024, p.hbuf, DM, 1024, !last, (bf16_t*)p.Yf);
            else if (s == 4) phase_rowupdate(p, l, 0);
            else if (s == 5) { EpiSwiglu e{p.Gact}; gemm_phase(lds, p.wt_gu + (size_t)l * 2 * FFN * 1024, 1024, p.hbuf, DM, 1024, (last ? NLAT : NT) / 128, 44, e); }
            else if (s == 6) gemm_phase_n1024(lds, p.wt_down + (size_t)l * 1024 * FFN, FFN, p.Gact, FFN, FFN, !last, (bf16_t*)p.Yf);
            else phase_rowupdate(p, l, 1);
        }
        if (ph + 1 < p.phase_end) { if (p.coop == 1) xcd_barrier(xb); else if (p.coop == 3) simple_barrier(p.counters + 32, (unsigned)(ph - p.phase_begin + 1) * gridDim.x); else if (p.coop == 2) cg::this_grid().sync(); }
    }
}

extern "C" void kernel_launch(void* const* d_in, const int* in_sizes, int n_in, void* d_out, int out_size, void* d_ws, size_t ws_size, hipStream_t stream) {
    static int grid = 0;
    if (grid == 0) {
        int dev = 0, cus = 0, per_cu = 0;
        hipGetDevice(&dev); hipDeviceGetAttribute(&cus, hipDeviceAttributeMultiprocessorCount, dev);
        hipFuncSetAttribute((const void*)fwd_kernel, hipFuncAttributeMaxDynamicSharedMemorySize, LDS_BYTES);
        hipOccupancyMaxActiveBlocksPerMultiprocessor(&per_cu, (const void*)fwd_kernel, NTHREADS, LDS_BYTES);
        per_cu = 2;
        grid = cus * per_cu;
        fprintf(stderr, "kernel_launch: cus %d per_cu %d grid %d ws %zu\n", cus, per_cu, grid, ws_size);
    }
    Params p{};
    { const float* inp[26]; for (int i = 0; i < 26; ++i) inp[i] = (const float*)d_in[i]; memcpy((void*)&p, inp, sizeof(inp)); }
    p.out = (float*)d_out;
    unsigned char* w = (unsigned char*)d_ws; size_t off = 0;
    auto take = [&](size_t bytes) { unsigned char* r = w + off; off += (bytes + 255) & ~(size_t)255; return r; };
    p.counters = (unsigned*)take(256 + XCD_BAR_WORDS * 4);
    p.wt_in = (bf16_t*)take((size_t)2 * INW * 1024 * 2);
    p.wt_qb = (bf16_t*)take((size_t)2 * 384 * 256 * 2);
    p.wt_kvb = (bf16_t*)take((size_t)2 * 512 * 128 * 2);
    p.wt_out = (bf16_t*)take((size_t)2 * 1024 * 1024 * 2);
    p.wt_gu = (bf16_t*)take((size_t)2 * 2 * FFN * 1024 * 2);
    p.wt_down = (bf16_t*)take((size_t)2 * 1024 * FFN * 2);
    p.adapart = (float*)take((size_t)2 * 16 * 3 * 6144 * 4);
    p.mod = (float*)take((size_t)2 * 3 * 6144 * 4);
    p.lam = (float*)take(256);
    p.cs16 = (float*)take((size_t)SEQ * 16 * 2 * 4);
    p.cs32 = (float*)take((size_t)SEQ * 32 * 2 * 4);
    p.xc = (float*)take((size_t)NB * CTXL * DM * 4);
    p.ssq = (float*)take((size_t)NT * 8 * 4);
    p.hbuf = (bf16_t*)take((size_t)NT * DM * 2);
    p.Yf = (float*)take((size_t)NT * DM * 4); p.qkva = (bf16_t*)p.Yf;
    unsigned char* ra = take((size_t)NT * FFN * 2); p.Gact = (bf16_t*)ra;
    { size_t o2 = 0; auto tk = [&](size_t bytes) { unsigned char* r = ra + o2; o2 += (bytes + 255) & ~(size_t)255; return (bf16_t*)r; };
      p.Qm = tk((size_t)NB * 4 * NKEY * 96 * 2); p.Km = tk((size_t)NB * 4 * NKEY * 96 * 2); p.VmT = tk((size_t)NB * 4 * 64 * NKEY * 2);
      p.Qd = tk((size_t)NB * 8 * NKEY * 32 * 2); p.Kd = tk((size_t)NB * 8 * NKEY * 32 * 2); p.VdT = tk((size_t)NB * 4 * 64 * NKEY * 2);
      p.Qg = tk((size_t)NB * 8 * NKEY * 64 * 2); p.Kg = tk((size_t)NB * 2 * NKEY * 64 * 2); p.VgT = tk((size_t)NB * 2 * 64 * NKEY * 2);
      if (o2 > (size_t)NT * FFN * 2) { fprintf(stderr, "kernel_launch: region RA overflow\n"); return; } }
    if (off > ws_size) { fprintf(stderr, "kernel_launch: workspace too small: need %zu have %zu\n", off, ws_size); return; }
    (void)hipMemsetAsync(p.counters, 0, 256 + XCD_BAR_WORDS * 4, stream);
#if ONE_LAUNCH
    p.phase_begin = 0; p.phase_end = N_PHASES; p.coop = 1;
    void* args[] = {&p};
    hipError_t e = hipLaunchCooperativeKernel((const void*)fwd_kernel, dim3(grid), dim3(NTHREADS), args, LDS_BYTES, stream);
    if (e != hipSuccess) fprintf(stderr, "cooperative launch failed: %s (grid %d)\n", hipGetErrorString(e), grid);
#else
    for (int ph = 0; ph < N_PHASES; ++ph) { p.phase_begin = ph; p.phase_end = ph + 1; p.coop = 0; hipLaunchKernelGGL(fwd_kernel, dim3(grid), dim3(NTHREADS), LDS_BYTES, stream, p); }
#endif
}
```

```cpp
#include <hip/hip_runtime.h>
#include <hip/hip_cooperative_groups.h>
#include <stdint.h>
#include <stdio.h>
#include <string.h>
namespace cg = cooperative_groups;

#ifndef ONE_LAUNCH
#define ONE_LAUNCH 1
#endif

typedef unsigned short bf16_t;
typedef short bf16x8 __attribute__((ext_vector_type(8)));
typedef float f32x16 __attribute__((ext_vector_type(16)));
typedef float f32x4 __attribute__((ext_vector_type(4)));
typedef float f32x2 __attribute__((ext_vector_type(2)));
typedef unsigned u32x4 __attribute__((ext_vector_type(4)));
typedef unsigned u32x2 __attribute__((ext_vector_type(2)));

constexpr int DM = 1024, NB = 2, SEQ = 8192, CTXL = 256, NKEY = SEQ + CTXL, NLAT = NB * SEQ, NT = NLAT + NB * CTXL;
constexpr int FFN = 2816, INW = 2048, DEPTH = 2;
constexpr float EPS = 1e-6f, LOG2E = 1.4426950408889634f;
constexpr float MLA_SC = 0.10206207261596577f * LOG2E, DIFF_SC = 0.17677669529663687f * LOG2E, GQA_SC = 0.125f * LOG2E;
constexpr int LDS_BYTES = 73728;
constexpr int NTHREADS = 256;

struct Params {
    const float *x, *c, *ctx, *c_ctx, *w_ada, *b_ada, *g_attn_pre, *g_attn_post, *w_in, *g_mla_q, *w_mla_qb, *g_mla_kv, *w_mla_kvb,
        *lq1, *lk1, *lq2, *lk2, *g_diff_sub, *g_gqa_q, *g_gqa_k, *w_out, *g_ffn_pre, *g_ffn_post, *w_gate, *w_up, *w_down;
    float* out;
    bf16_t *wt_in, *wt_qb, *wt_kvb, *wt_out, *wt_gu, *wt_down;
    float *adapart, *mod, *lam, *cs16, *cs32, *xc, *ssq, *Yf;
    bf16_t *hbuf, *qkva, *Qm, *Km, *VmT, *Qd, *Kd, *VdT, *Qg, *Kg, *VgT, *Gact;
    unsigned* counters;
    int phase_begin, phase_end, coop, pad;
};

typedef __bf16 bf16x2_t __attribute__((ext_vector_type(2)));
__device__ __forceinline__ unsigned pk_bf16(float lo, float hi) { const f32x2 v = {lo, hi}; const bf16x2_t b = __builtin_convertvector(v, bf16x2_t); return __builtin_bit_cast(unsigned, b); }
__device__ __forceinline__ int otid() { int t = threadIdx.x; asm volatile("" : "+v"(t)); return t; }
__device__ __forceinline__ float fexp2(float x) { return __builtin_amdgcn_exp2f(x); }
__device__ __forceinline__ float max3f(float a, float b, float c) { float r; asm("v_max3_f32 %0, %1, %2, %3" : "=v"(r) : "v"(a), "v"(b), "v"(c)); return r; }
__device__ __forceinline__ float xhalf_max(float x) { return fmaxf(x, __shfl_xor(x, 32)); }
__device__ __forceinline__ float xhalf_sum(float x) { return x + __shfl_xor(x, 32); }
__device__ __forceinline__ float frsq(float x) { return __builtin_amdgcn_rsqf(x); }
__device__ __forceinline__ float wave_sum(float v) {
#pragma unroll
    for (int o = 32; o >= 1; o >>= 1) v += __shfl_xor(v, o);
    return v;
}
__device__ __forceinline__ void tok_decode(int t, int& b, int& j) { if (t < NLAT) { b = t >> 13; j = t & (SEQ - 1); } else { const int c = t - NLAT; b = c >> 8; j = SEQ + (c & (CTXL - 1)); } }
__device__ __forceinline__ const float* xin_row(const Params& p, int l, int t) {
    if (l == 0) return t < NLAT ? p.x + (size_t)t * DM : p.ctx + (size_t)(t - NLAT) * DM;
    return t < NLAT ? p.out + (size_t)t * DM : p.xc + (size_t)(t - NLAT) * DM;
}
__device__ __forceinline__ float* xw_row(const Params& p, int t) { return t < NLAT ? p.out + (size_t)t * DM : p.xc + (size_t)(t - NLAT) * DM; }
__device__ __forceinline__ int mod_vec(int t) { return t < NLAT ? (t >> 13) : 2; }

#define LASP __attribute__((address_space(3)))
typedef float f32x4acc __attribute__((ext_vector_type(4)));
template <class Epi>
__device__ __forceinline__ void gemm_tile(unsigned char* lds, const bf16_t* __restrict__ W, int ldw, const bf16_t* __restrict__ A, int lda, int K, int n0, int t0, const Epi& epi) {
    const int tid = otid(), lane = tid & 63, wid = tid >> 6, wn = wid >> 1, wt = wid & 1;
    const int dr = lane >> 3, dp = lane & 7;
    unsigned woff[4], aoff[4];
#pragma unroll
    for (int j = 0; j < 4; ++j) { const int row = (wid * 4 + j) * 8 + dr, c = dp ^ ((row >> 1) & 7);
        woff[j] = (unsigned)((n0 + row) * ldw + c * 8); aoff[j] = (unsigned)((t0 + row) * lda + c * 8); }
    const unsigned lbase = (unsigned)(size_t)lds + (unsigned)wid * 4096u;
    f32x4 acc[4][4];
#pragma unroll
    for (int a = 0; a < 4; ++a)
#pragma unroll
        for (int b = 0; b < 4; ++b) acc[a][b] = (f32x4){0.f, 0.f, 0.f, 0.f};
#define GT_DMA(kt_, st_) do { _Pragma("unroll") for (int j = 0; j < 4; ++j) { \
        __builtin_amdgcn_global_load_lds((const unsigned*)(W + woff[j] + (size_t)(kt_) * 64), (LASP unsigned*)(lbase + (unsigned)(st_) * 32768u + (unsigned)j * 1024u), 16, 0, 0); \
        __builtin_amdgcn_global_load_lds((const unsigned*)(A + aoff[j] + (size_t)(kt_) * 64), (LASP unsigned*)(lbase + (unsigned)(st_) * 32768u + 16384u + (unsigned)j * 1024u), 16, 0, 0); } } while (0)
    const int r16 = lane & 15, q = lane >> 4, sw = r16 >> 1;
    const int base_w = (wn * 64 + r16) * 128, base_a = 16384 + (wt * 64 + r16) * 128;
    const int nk = K >> 6;
    GT_DMA(0, 0);
    asm volatile("s_waitcnt vmcnt(0)" ::: "memory");
    __syncthreads();
    for (int kt = 0; kt < nk; ++kt) {
        const int st = kt & 1;
        if (kt + 1 < nk) GT_DMA(kt + 1, st ^ 1);
        const unsigned char* sb = lds + st * 32768;
#pragma unroll
        for (int ks = 0; ks < 2; ++ks) {
            const int pos = ((ks * 4 + q) ^ sw) * 16;
            bf16x8 fa[4], fb[4];
#pragma unroll
            for (int i = 0; i < 4; ++i) { fa[i] = *(const bf16x8*)(sb + base_w + i * 2048 + pos); fb[i] = *(const bf16x8*)(sb + base_a + i * 2048 + pos); }
#pragma unroll
            for (int ni = 0; ni < 4; ++ni)
#pragma unroll
                for (int ti = 0; ti < 4; ++ti) acc[ni][ti] = __builtin_amdgcn_mfma_f32_16x16x32_bf16(fa[ni], fb[ti], acc[ni][ti], 0, 0, 0);
        }
        asm volatile("s_waitcnt vmcnt(0)" ::: "memory");
        __syncthreads();
    }
#undef GT_DMA
    epi(acc, n0 + wn * 64, t0 + wt * 64, lane);
}

__device__ __forceinline__ bool gemm_unit(int u, int ntt, int nn, int& tt, int& nt) {
    const int xcd = u & 7, v = u >> 3; nt = v % nn; tt = (v / nn) * 8 + xcd; return tt < ntt;
}
__device__ __forceinline__ void store4(bf16_t* dst, const f32x4& v);
__device__ __forceinline__ void gemm_tile_small(unsigned char* lds, const bf16_t* __restrict__ W, int ldw, const bf16_t* __restrict__ A, int lda, int K, int n0, int t0, bf16_t* O, int ldo) {
    const int tid = otid(), lane = tid & 63, wid = tid >> 6;
    const int dr = lane >> 3, dp = lane & 7;
    unsigned woff[4], aoff;
#pragma unroll
    for (int j = 0; j < 4; ++j) { const int row = (wid * 4 + j) * 8 + dr, c = dp ^ ((row >> 1) & 7); woff[j] = (unsigned)((n0 + row) * ldw + c * 8); }
    { const int row = wid * 8 + dr, c = dp ^ ((row >> 1) & 7); aoff = (unsigned)((t0 + row) * lda + c * 8); }
    const unsigned lbase = (unsigned)(size_t)lds;
    f32x4 acc[2][2];
#pragma unroll
    for (int a = 0; a < 2; ++a) { acc[a][0] = (f32x4){0.f, 0.f, 0.f, 0.f}; acc[a][1] = (f32x4){0.f, 0.f, 0.f, 0.f}; }
#define GS_DMA(kt_, st_) do { _Pragma("unroll") for (int j = 0; j < 4; ++j) \
        __builtin_amdgcn_global_load_lds((const unsigned*)(W + woff[j] + (size_t)(kt_) * 64), (LASP unsigned*)(lbase + (unsigned)(st_) * 32768u + (unsigned)wid * 4096u + (unsigned)j * 1024u), 16, 0, 0); \
        __builtin_amdgcn_global_load_lds((const unsigned*)(A + aoff + (size_t)(kt_) * 64), (LASP unsigned*)(lbase + (unsigned)(st_) * 32768u + 16384u + (unsigned)wid * 1024u), 16, 0, 0); } while (0)
    const int r16 = lane & 15, q = lane >> 4, sw = r16 >> 1;
    const int base_w = (wid * 32 + r16) * 128, base_a = 16384 + r16 * 128;
    const int nk = K >> 6;
    GS_DMA(0, 0);
    asm volatile("s_waitcnt vmcnt(0)" ::: "memory");
    __syncthreads();
    for (int kt = 0; kt < nk; ++kt) {
        const int st = kt & 1;
        if (kt + 1 < nk) GS_DMA(kt + 1, st ^ 1);
        const unsigned char* sb = lds + st * 32768;
#pragma unroll
        for (int ks = 0; ks < 2; ++ks) {
            const int pos = ((ks * 4 + q) ^ sw) * 16;
            bf16x8 fa[2], fb[2];
#pragma unroll
            for (int i = 0; i < 2; ++i) { fa[i] = *(const bf16x8*)(sb + base_w + i * 2048 + pos); fb[i] = *(const bf16x8*)(sb + base_a + i * 2048 + pos); }
#pragma unroll
            for (int ni = 0; ni < 2; ++ni)
#pragma unroll
                for (int ti = 0; ti < 2; ++ti) acc[ni][ti] = __builtin_amdgcn_mfma_f32_16x16x32_bf16(fa[ni], fb[ti], acc[ni][ti], 0, 0, 0);
        }
        asm volatile("s_waitcnt vmcnt(0)" ::: "memory");
        __syncthreads();
    }
#undef GS_DMA
#pragma unroll
    for (int ti = 0; ti < 2; ++ti) { bf16_t* row = O + (size_t)(t0 + ti * 16 + r16) * ldo + n0 + wid * 32 + 4 * q;
#pragma unroll
        for (int ni = 0; ni < 2; ++ni) store4(row + ni * 16, acc[ni][ti]); }
}
__device__ __forceinline__ void gemm_phase_n1024(unsigned char* lds, const bf16_t* W, int ldw, const bf16_t* A, int lda, int K, bool with_ctx, bf16_t* O);

template <class Epi>
__device__ __forceinline__ void gemm_phase(unsigned char* lds, const bf16_t* W, int ldw, const bf16_t* A, int lda, int K, int ntt, int nn, const Epi& epi) {
    const int x = blockIdx.x & 7, j = blockIdx.x >> 3, stride = gridDim.x >> 3;
    const int ntx = (ntt - x + 7) >> 3;
    const int total = ntx * nn;
    for (int i = j; i < total; i += stride) {
        int tg = 0, rem = i;
        for (;;) { const int tc = min(8, ntx - 8 * tg); if (rem < tc * nn) break; rem -= tc * nn; ++tg; }
        const int tc = min(8, ntx - 8 * tg);
        const int ng = rem / (tc * 8), r2 = rem - ng * tc * 8;
        const int nl = r2 / tc, tl = r2 - nl * tc;
        const int nt = ng * 8 + nl, tt = (tg * 8 + tl) * 8 + x;
        gemm_tile(lds, W, ldw, A, lda, K, nt * 128, tt * 128, epi);
    }
}

__device__ __forceinline__ void store4(bf16_t* dst, const f32x4& v) { u32x2 w; w.x = pk_bf16(v[0], v[1]); w.y = pk_bf16(v[2], v[3]); *(u32x2*)dst = w; }
__device__ __forceinline__ float quad_sum(float v) { v += __shfl_xor(v, 16); v += __shfl_xor(v, 32); return v; }
__device__ __forceinline__ float sumsq4(const f32x4& v) { return v[0] * v[0] + v[1] * v[1] + v[2] * v[2] + v[3] * v[3]; }
__device__ __forceinline__ void rope4(f32x4& x1, f32x4& x2, const float* cs) {
    const f32x4 c01 = *(const f32x4*)cs, c23 = *(const f32x4*)(cs + 4);
    const f32x4 cc = {c01[0], c01[2], c23[0], c23[2]}, sn = {c01[1], c01[3], c23[1], c23[3]};
    const f32x4 a = x1 * cc - x2 * sn, b = x2 * cc + x1 * sn; x1 = a; x2 = b;
}

struct EpiInProj {
    const Params* pp; int l;
    __device__ __forceinline__ void operator()(f32x4 (&acc)[4][4], int nb0, int tb0, int lane) const {
        const Params& p = *pp; const int q = lane >> 4, r16 = lane & 15;
#pragma unroll
        for (int ti = 0; ti < 4; ++ti) {
            const int t = tb0 + ti * 16 + r16; int b, j; tok_decode(t, b, j); const bool lat = j < SEQ;
            if (nb0 < 384) {
                float ss = 0.f;
#pragma unroll
                for (int ni = 0; ni < 4; ++ni) { ss += sumsq4(acc[ni][ti]); store4(p.qkva + (size_t)t * 384 + nb0 + ni * 16 + 4 * q, acc[ni][ti]); }
                ss = quad_sum(ss);
                if (q == 0) p.ssq[(size_t)t * 8 + (nb0 >> 6)] = ss;
            } else if (nb0 < 896) {
                const bool isq = nb0 < 640;
#pragma unroll
                for (int mp = 0; mp < 2; ++mp) { f32x4 x1 = acc[2 * mp][ti], x2 = acc[2 * mp + 1][ti];
                    if (lat) rope4(x1, x2, p.cs16 + ((size_t)j * 16 + 4 * q) * 2);
                    if (isq) { x1 *= DIFF_SC; x2 *= DIFF_SC; }
                    const int map = ((nb0 - (isq ? 384 : 640)) >> 5) + mp;
                    bf16_t* dst = (isq ? p.Qd : p.Kd) + ((size_t)(b * 8 + map) * NKEY + j) * 32 + 4 * q;
                    store4(dst, x1); store4(dst + 16, x2); }
            } else if (nb0 < 1152 || (nb0 >= 1792 && nb0 < 1920)) {
                const bool isd = nb0 < 1152; const int hd = isd ? (nb0 - 896) >> 6 : (nb0 - 1792) >> 6;
                bf16_t* base = (isd ? p.VdT + (size_t)(b * 4 + hd) * 64 * NKEY : p.VgT + (size_t)(b * 2 + hd) * 64 * NKEY) + j;
#pragma unroll
                for (int ni = 0; ni < 4; ++ni)
#pragma unroll
                    for (int e = 0; e < 4; ++e) base[(size_t)(ni * 16 + 4 * q + e) * NKEY] = (bf16_t)(pk_bf16(acc[ni][ti][e], 0.f) & 0xffffu);
            } else if (nb0 < 1792) {
                const bool isq = nb0 < 1664; const int head = isq ? (nb0 - 1152) >> 6 : (nb0 - 1664) >> 6;
                const float* g = (isq ? p.g_gqa_q : p.g_gqa_k) + l * 64;
                float ss = 0.f;
#pragma unroll
                for (int ni = 0; ni < 4; ++ni) ss += sumsq4(acc[ni][ti]);
                ss = quad_sum(ss);
                const float rinv = frsq(ss * (1.f / 64.f) + EPS);
                bf16_t* dst = (isq ? p.Qg + ((size_t)(b * 8 + head) * NKEY + j) * 64 : p.Kg + ((size_t)(b * 2 + head) * NKEY + j) * 64);
#pragma unroll
                for (int mp = 0; mp < 2; ++mp) { const int d0 = mp * 16 + 4 * q;
                    f32x4 x1 = acc[mp][ti] * rinv * *(const f32x4*)(g + d0), x2 = acc[mp + 2][ti] * rinv * *(const f32x4*)(g + 32 + d0);
                    if (lat) rope4(x1, x2, p.cs32 + ((size_t)j * 32 + d0) * 2);
                    if (isq) { x1 *= GQA_SC; x2 *= GQA_SC; }
                    store4(dst + d0, x1); store4(dst + 32 + d0, x2); }
            } else if (nb0 == 1920) {
                f32x4 x1 = acc[0][ti], x2 = acc[1][ti];
                if (lat) rope4(x1, x2, p.cs16 + ((size_t)j * 16 + 4 * q) * 2);
#pragma unroll
                for (int hh = 0; hh < 4; ++hh) { bf16_t* dst = p.Km + ((size_t)(b * 4 + hh) * NKEY + j) * 96 + 64 + 4 * q; store4(dst, x1); store4(dst + 16, x2); }
            }
        }
    }
};

struct EpiMlaQ {
    const Params* pp;
    __device__ __forceinline__ void operator()(f32x4 (&acc)[4][4], int nb0, int tb0, int lane) const {
        const Params& p = *pp; const int q = lane >> 4, r16 = lane & 15;
#pragma unroll
        for (int ti = 0; ti < 4; ++ti) {
            const int t = tb0 + ti * 16 + r16; int b, j; tok_decode(t, b, j); const bool lat = j < SEQ;
            const f32x4 s4 = *(const f32x4*)(p.ssq + (size_t)t * 8);
            const float rq = frsq((s4[0] + s4[1] + s4[2] + s4[3]) * (1.f / 256.f) + EPS) * MLA_SC;
#pragma unroll
            for (int ni = 0; ni < 4; ++ni) {
                const int k16 = (nb0 >> 4) + ni, head = k16 / 6, part = k16 - head * 6;
                bf16_t* dst = p.Qm + ((size_t)(b * 4 + head) * NKEY + j) * 96 + part * 16 + 4 * q;
                if (part < 4) store4(dst, acc[ni][ti] * rq);
                else if (part == 4) { if (ni < 3) { f32x4 x1 = acc[ni][ti] * rq, x2 = acc[ni < 3 ? ni + 1 : ni][ti] * rq;
                    if (lat) rope4(x1, x2, p.cs16 + ((size_t)j * 16 + 4 * q) * 2);
                    store4(dst, x1); store4(dst + 16, x2); } }
            }
        }
    }
};
struct EpiMlaKV {
    const Params* pp;
    __device__ __forceinline__ void operator()(f32x4 (&acc)[4][4], int nb0, int tb0, int lane) const {
        const Params& p = *pp; const int q = lane >> 4, r16 = lane & 15;
        const int head = nb0 >> 7; const bool isv = (nb0 & 64) != 0;
#pragma unroll
        for (int ti = 0; ti < 4; ++ti) {
            const int t = tb0 + ti * 16 + r16; int b, j; tok_decode(t, b, j);
            const float rkv = frsq((p.ssq[(size_t)t * 8 + 4] + p.ssq[(size_t)t * 8 + 5]) * (1.f / 128.f) + EPS);
#pragma unroll
            for (int ni = 0; ni < 4; ++ni) {
                if (!isv) store4(p.Km + ((size_t)(b * 4 + head) * NKEY + j) * 96 + ni * 16 + 4 * q, acc[ni][ti] * rkv);
                else { bf16_t* base = p.VmT + (size_t)(b * 4 + head) * 64 * NKEY + j;
#pragma unroll
                    for (int e = 0; e < 4; ++e) base[(size_t)(ni * 16 + 4 * q + e) * NKEY] = (bf16_t)(pk_bf16(acc[ni][ti][e] * rkv, 0.f) & 0xffffu); }
            }
        }
    }
};
struct EpiBf16Out {
    bf16_t* O; int ldo;
    __device__ __forceinline__ void operator()(f32x4 (&acc)[4][4], int nb0, int tb0, int lane) const {
        const int q = lane >> 4, r16 = lane & 15;
#pragma unroll
        for (int ti = 0; ti < 4; ++ti) { bf16_t* row = O + (size_t)(tb0 + ti * 16 + r16) * ldo + nb0 + 4 * q;
#pragma unroll
            for (int ni = 0; ni < 4; ++ni) store4(row + ni * 16, acc[ni][ti]); }
    }
};
__device__ __forceinline__ void gemm_phase_n1024(unsigned char* lds, const bf16_t* W, int ldw, const bf16_t* A, int lda, int K, bool with_ctx, bf16_t* O) {
    EpiBf16Out e{O, DM};
    gemm_phase(lds, W, ldw, A, lda, K, NLAT / 128, 8, e);
    if (with_ctx) {
        if (gridDim.x == 512) {
            if (((blockIdx.x >> 3) & 3) == 0) { const int u = (blockIdx.x >> 5) * 8 + (blockIdx.x & 7); gemm_tile_small(lds, W, ldw, A, lda, K, (u & 7) * 128, NLAT + (u >> 3) * 32, O, DM); }
        } else for (int u = blockIdx.x; u < 128; u += gridDim.x) gemm_tile_small(lds, W, ldw, A, lda, K, (u & 7) * 128, NLAT + (u >> 3) * 32, O, DM);
    }
}
struct EpiSwiglu {
    bf16_t* G;
    __device__ __forceinline__ void operator()(f32x4 (&acc)[4][4], int nb0, int tb0, int lane) const {
        const int q = lane >> 4, r16 = lane & 15;
#pragma unroll
        for (int ti = 0; ti < 4; ++ti) { bf16_t* row = G + (size_t)(tb0 + ti * 16 + r16) * FFN + ((nb0 >> 5) * 16) + 4 * q;
#pragma unroll
            for (int mp = 0; mp < 2; ++mp) { f32x4 a;
#pragma unroll
                for (int e = 0; e < 4; ++e) { const float g = acc[2 * mp][ti][e], u = acc[2 * mp + 1][ti][e]; a[e] = g * __builtin_amdgcn_rcpf(1.f + fexp2(-g * LOG2E)) * u; }
                store4(row + mp * 16, a); } }
    }
};

template <int DQK>
__device__ __forceinline__ void attn_pipe(unsigned char* lds, const bf16_t* __restrict__ Qw, const bf16_t* __restrict__ Kh, const bf16_t* __restrict__ VTh, int kt0, int kt1, f32x16 (&O)[2], float& lfin) {
    constexpr int KMAIN = DQK >= 64 ? 8192 : 4096, KROPE = DQK == 96 ? 4096 : 0, VOFF = KMAIN + KROPE, STG = VOFF + 8192;
    constexpr int NPW = DQK == 96 ? 5 : (DQK == 64 ? 4 : 3);
    static_assert(3 * STG <= LDS_BYTES, "three stages must fit");
    const int tid = otid(), lane = tid & 63, wid = tid >> 6, h = lane >> 5, lr = lane & 31;
    const int pr = (lr & ~12) | ((lr & 4) << 1) | ((lr & 8) >> 1);
    bf16x8 qf[DQK / 16];
#pragma unroll
    for (int ks = 0; ks < DQK / 16; ++ks) qf[ks] = *(const bf16x8*)(Qw + (size_t)lr * DQK + ks * 16 + 8 * h);
#pragma unroll
    for (int r = 0; r < 16; ++r) { O[0][r] = 0.f; O[1][r] = 0.f; }
    float m = 0.f, lsum = 0.f; bool has_ref = false;
    const int n = kt1 - kt0;
    unsigned soff[NPW], doff[NPW];
    {
        const int r8 = lane >> 3, p8 = lane & 7, r4 = lane >> 2, p4 = lane & 3;
        if (DQK >= 64) {
#pragma unroll
            for (int i = 0; i < 2; ++i) { const int g = wid + 4 * i, row = 8 * g + r8; soff[i] = (unsigned)(row * DQK + (p8 ^ ((row >> 1) & 7)) * 8); doff[i] = (unsigned)(g * 1024); }
            if (DQK == 96) { const int row = 16 * wid + r4; soff[2] = (unsigned)(row * DQK + 64 + (p4 ^ ((row >> 2) & 3)) * 8); doff[2] = (unsigned)(KMAIN + wid * 1024); }
        } else { const int row = 16 * wid + r4; soff[0] = (unsigned)(row * DQK + (p4 ^ ((row >> 2) & 3)) * 8); doff[0] = (unsigned)(wid * 1024); }
#pragma unroll
        for (int i = 0; i < 2; ++i) { const int g = wid + 4 * i, row = 8 * g + r8; soff[NPW - 2 + i] = (unsigned)(row * NKEY + (p8 ^ ((row >> 1) & 7)) * 8); doff[NPW - 2 + i] = (unsigned)(VOFF + g * 1024); }
    }
    const unsigned lbase = (unsigned)(size_t)lds;
#define AP_DMA(kt_, off_) do { \
        _Pragma("unroll") for (int i = 0; i < NPW - 2; ++i) __builtin_amdgcn_global_load_lds((const unsigned*)(Kh + (size_t)(kt_) * 64 * DQK + soff[i]), (LASP unsigned*)(lbase + (unsigned)(off_) + doff[i]), 16, 0, 0); \
        _Pragma("unroll") for (int i = NPW - 2; i < NPW; ++i) __builtin_amdgcn_global_load_lds((const unsigned*)(VTh + (size_t)(kt_) * 64 + soff[i]), (LASP unsigned*)(lbase + (unsigned)(off_) + doff[i]), 16, 0, 0); } while (0)
    const int swk = (pr >> 1) & 7, swr = (pr >> 2) & 3, swv = (lr >> 1) & 7;
#define AP_KADDR(ks_) (DQK >= 64 ? ((ks_) < 4 ? pr * 128 + (((ks_) * 2 + h) ^ swk) * 16 : KMAIN + pr * 64 + ((((ks_) - 4) * 2 + h) ^ swr) * 16) : pr * 64 + (((ks_) * 2 + h) ^ swr) * 16)
#define AP_KROW32(ks_) ((DQK >= 64 && (ks_) < 4) ? 32 * 128 : 32 * 64)
#define AP_QKCHAIN(Sx0, Sx1, kb_) do { _Pragma("unroll") for (int ks = 0; ks < DQK / 16; ++ks) { \
            const bf16x8 k0_ = *(const bf16x8*)((kb_) + AP_KADDR(ks)), k1_ = *(const bf16x8*)((kb_) + AP_KADDR(ks) + AP_KROW32(ks)); \
            Sx0 = __builtin_amdgcn_mfma_f32_32x32x16_bf16(k0_, qf[ks], Sx0, 0, 0, 0); Sx1 = __builtin_amdgcn_mfma_f32_32x32x16_bf16(k1_, qf[ks], Sx1, 0, 0, 0); } } while (0)
#define AP_QK(Sx0, Sx1, off_) do { const unsigned char* kbq_ = lds + (off_); \
        if (has_ref) { const float ni_ = -m; _Pragma("unroll") for (int r = 0; r < 16; ++r) { Sx0[r] = ni_; Sx1[r] = ni_; } AP_QKCHAIN(Sx0, Sx1, kbq_); } \
        else { _Pragma("unroll") for (int r = 0; r < 16; ++r) { Sx0[r] = 0.f; Sx1[r] = 0.f; } AP_QKCHAIN(Sx0, Sx1, kbq_); } } while (0)
#define AP_BODY(t_, Sc0, Sc1, Sn0, Sn1, DMA_, NXT_) do { \
        constexpr bool nxt_ = NXT_; \
        if (DMA_) AP_DMA(kt0 + (t_) + 2, ow); \
        if (nxt_) AP_QK(Sn0, Sn1, ok); \
        if (((t_) & 3) == 0) {   \
        const float seed_ = fmaxf(Sc0[15], Sc1[15]); \
        float mxa_ = max3f(seed_, Sc0[0], Sc0[1]), mxb_ = max3f(seed_, Sc1[0], Sc1[1]); \
        _Pragma("unroll") for (int r = 2; r < 14; r += 2) { mxa_ = max3f(mxa_, Sc0[r], Sc0[r + 1]); mxb_ = max3f(mxb_, Sc1[r], Sc1[r + 1]); } \
        float mx_ = max3f(mxa_, mxb_, Sc0[14]); mx_ = max3f(mx_, Sc1[14], mx_); mx_ = xhalf_max(mx_); \
        const bool first_ = (t_) == 0; \
        if (__any(mx_ > 40.f || (first_ && mx_ < -40.f))) { \
            const float dm_ = (mx_ > 40.f || (first_ && mx_ < -40.f)) ? mx_ : 0.f; \
            if (!first_) { const float al_ = fexp2(-dm_); lsum *= al_; _Pragma("unroll") for (int r = 0; r < 16; ++r) { O[0][r] *= al_; O[1][r] *= al_; } } \
            m += dm_; has_ref = true; \
            _Pragma("unroll") for (int r = 0; r < 16; ++r) { Sc0[r] -= dm_; Sc1[r] -= dm_; } \
            if (nxt_) { _Pragma("unroll") for (int r = 0; r < 16; ++r) { Sn0[r] -= dm_; Sn1[r] -= dm_; } } \
        } } \
        float ps_ = 0.f, pt_ = 0.f; \
        _Pragma("unroll") for (int r = 0; r < 16; ++r) { Sc0[r] = fexp2(Sc0[r]); Sc1[r] = fexp2(Sc1[r]); ps_ += Sc0[r]; pt_ += Sc1[r]; } \
        lsum += ps_ + pt_; \
        u32x4 pw_[4]; \
        _Pragma("unroll") for (int q = 0; q < 2; ++q) { const int o = q * 8; \
            pw_[q].x = pk_bf16(Sc0[o], Sc0[o + 1]); pw_[q].y = pk_bf16(Sc0[o + 2], Sc0[o + 3]); pw_[q].z = pk_bf16(Sc0[o + 4], Sc0[o + 5]); pw_[q].w = pk_bf16(Sc0[o + 6], Sc0[o + 7]); \
            pw_[2 + q].x = pk_bf16(Sc1[o], Sc1[o + 1]); pw_[2 + q].y = pk_bf16(Sc1[o + 2], Sc1[o + 3]); pw_[2 + q].z = pk_bf16(Sc1[o + 4], Sc1[o + 5]); pw_[2 + q].w = pk_bf16(Sc1[o + 6], Sc1[o + 7]); } \
        { const unsigned char* vb_ = lds + ov + VOFF + lr * 128; \
          _Pragma("unroll") for (int ksp = 0; ksp < 4; ++ksp) { const int vp_ = ((ksp * 2 + h) ^ swv) * 16; const bf16x8 v0_ = *(const bf16x8*)(vb_ + vp_), v1_ = *(const bf16x8*)(vb_ + 32 * 128 + vp_); const bf16x8 pc_ = __builtin_bit_cast(bf16x8, pw_[ksp]); \
              O[0] = __builtin_amdgcn_mfma_f32_32x32x16_bf16(v0_, pc_, O[0], 0, 0, 0); O[1] = __builtin_amdgcn_mfma_f32_32x32x16_bf16(v1_, pc_, O[1], 0, 0, 0); } } \
        asm volatile("s_waitcnt vmcnt(0)" ::: "memory");     \
        __syncthreads(); \
        { const int tmp_ = ov; ov = ok; ok = ow; ow = tmp_; } } while (0)
    int ov = 0, ok = STG, ow = 2 * STG;
    f32x16 Sa0, Sa1, Sb0, Sb1;
    AP_DMA(kt0, 0); AP_DMA(kt0 + 1, STG);
    asm volatile("s_waitcnt vmcnt(0)" ::: "memory");
    __syncthreads();
    AP_QK(Sa0, Sa1, 0);
    int t = 0;
    for (; t < n - 2; t += 2) {
        AP_BODY(t, Sa0, Sa1, Sb0, Sb1, true, true);
        AP_BODY(t + 1, Sb0, Sb1, Sa0, Sa1, true, true);
    }
    AP_BODY(t, Sa0, Sa1, Sb0, Sb1, false, true);
    AP_BODY(t + 1, Sb0, Sb1, Sa0, Sa1, false, false);
#undef AP_DMA
#undef AP_KADDR
#undef AP_KROW32
#undef AP_QKCHAIN
#undef AP_QK
#undef AP_BODY
    lfin = xhalf_sum(lsum);
}

__device__ __forceinline__ void attn_gqa2(unsigned char* lds, const bf16_t* __restrict__ Qw, const bf16_t* __restrict__ Kh, const bf16_t* __restrict__ VTh, int kt0, int kt1, f32x16 (&O)[2][2], float (&lfin)[2]) {
    constexpr int DQK = 64, VOFF = 8192, STG = 16384;
    const int tid = otid(), lane = tid & 63, wid = tid >> 6, h = lane >> 5, lr = lane & 31;
    const int pr = (lr & ~12) | ((lr & 4) << 1) | ((lr & 8) >> 1);
    bf16x8 qf[2][4];
#pragma unroll
    for (int c = 0; c < 2; ++c)
#pragma unroll
        for (int ks = 0; ks < 4; ++ks) qf[c][ks] = *(const bf16x8*)(Qw + (size_t)(c * 32 + lr) * DQK + ks * 16 + 8 * h);
#pragma unroll
    for (int c = 0; c < 2; ++c)
#pragma unroll
        for (int r = 0; r < 16; ++r) { O[c][0][r] = 0.f; O[c][1][r] = 0.f; }
    float m[2] = {0.f, 0.f}, lsum[2] = {0.f, 0.f}; bool has_ref = false;
    const int n = kt1 - kt0;
    unsigned soff[4], doff[4];
    { const int r8 = lane >> 3, p8 = lane & 7;
#pragma unroll
      for (int i = 0; i < 2; ++i) { const int g = wid + 4 * i, row = 8 * g + r8, c = p8 ^ ((row >> 1) & 7);
          soff[i] = (unsigned)(row * DQK + c * 8); doff[i] = (unsigned)(g * 1024); soff[2 + i] = (unsigned)(row * NKEY + c * 8); doff[2 + i] = (unsigned)(VOFF + g * 1024); } }
    const unsigned lbase = (unsigned)(size_t)lds;
#define G2_DMA(kt_, off_) do { \
        _Pragma("unroll") for (int i = 0; i < 2; ++i) __builtin_amdgcn_global_load_lds((const unsigned*)(Kh + (size_t)(kt_) * 64 * DQK + soff[i]), (LASP unsigned*)(lbase + (unsigned)(off_) + doff[i]), 16, 0, 0); \
        _Pragma("unroll") for (int i = 2; i < 4; ++i) __builtin_amdgcn_global_load_lds((const unsigned*)(VTh + (size_t)(kt_) * 64 + soff[i]), (LASP unsigned*)(lbase + (unsigned)(off_) + doff[i]), 16, 0, 0); } while (0)
    const int swk = (pr >> 1) & 7, swv = (lr >> 1) & 7;
    G2_DMA(kt0, 0);
    asm volatile("s_waitcnt vmcnt(0)" ::: "memory");
    __syncthreads();
    for (int t = 0; t < n; ++t) {
        const int so = (t & 1) * STG;
        if (t + 1 < n) G2_DMA(kt0 + t + 1, STG - so);
        const bool chk = (t & 3) == 0, first = t == 0;
        u32x4 pw[2][4];
        f32x16 S[2][2];
#define G2_QK2() do { const unsigned char* kb = lds + so + pr * 128; bf16x8 kf[8]; \
        _Pragma("unroll") for (int ks = 0; ks < 4; ++ks) { const int kp = ((ks * 2 + h) ^ swk) * 16; kf[2 * ks] = *(const bf16x8*)(kb + kp); kf[2 * ks + 1] = *(const bf16x8*)(kb + 32 * 128 + kp); } \
        _Pragma("unroll") for (int ks = 0; ks < 4; ++ks) { S[0][0] = __builtin_amdgcn_mfma_f32_32x32x16_bf16(kf[2 * ks], qf[0][ks], S[0][0], 0, 0, 0); S[0][1] = __builtin_amdgcn_mfma_f32_32x32x16_bf16(kf[2 * ks + 1], qf[0][ks], S[0][1], 0, 0, 0); } \
        _Pragma("unroll") for (int ks = 0; ks < 4; ++ks) { S[1][0] = __builtin_amdgcn_mfma_f32_32x32x16_bf16(kf[2 * ks], qf[1][ks], S[1][0], 0, 0, 0); S[1][1] = __builtin_amdgcn_mfma_f32_32x32x16_bf16(kf[2 * ks + 1], qf[1][ks], S[1][1], 0, 0, 0); } } while (0)
        if (has_ref) {
#pragma unroll
            for (int c = 0; c < 2; ++c) { const float ni = -m[c];
#pragma unroll
                for (int r = 0; r < 16; ++r) { S[c][0][r] = ni; S[c][1][r] = ni; } }
            G2_QK2();
        } else {
#pragma unroll
            for (int c = 0; c < 2; ++c)
#pragma unroll
                for (int r = 0; r < 16; ++r) { S[c][0][r] = 0.f; S[c][1][r] = 0.f; }
            G2_QK2();
        }
#undef G2_QK2
        __builtin_amdgcn_sched_barrier(0);
        bf16x8 vf[8];
#pragma unroll
        for (int c = 0; c < 2; ++c) {
            if (chk) {
                const float seed = fmaxf(S[c][0][15], S[c][1][15]);
                float mxa = max3f(seed, S[c][0][0], S[c][0][1]), mxb = max3f(seed, S[c][1][0], S[c][1][1]);
#pragma unroll
                for (int r = 2; r < 14; r += 2) { mxa = max3f(mxa, S[c][0][r], S[c][0][r + 1]); mxb = max3f(mxb, S[c][1][r], S[c][1][r + 1]); }
                float mx = max3f(mxa, mxb, S[c][0][14]); mx = max3f(mx, S[c][1][14], mx);
                if (__any(first || mx > 40.f)) {
                    const float mq = xhalf_max(mx);
                    const float dm = (mq > 40.f || (first && mq < -40.f)) ? mq : 0.f;
                    if (!first) { const float al = fexp2(-dm); lsum[c] *= al;
#pragma unroll
                        for (int r = 0; r < 16; ++r) { O[c][0][r] *= al; O[c][1][r] *= al; } }
                    m[c] += dm; has_ref = true;
#pragma unroll
                    for (int r = 0; r < 16; ++r) { S[c][0][r] -= dm; S[c][1][r] -= dm; }
                }
            }
            float ps = 0.f, pt = 0.f;
#pragma unroll
            for (int r = 0; r < 16; ++r) { S[c][0][r] = fexp2(S[c][0][r]); S[c][1][r] = fexp2(S[c][1][r]); ps += S[c][0][r]; pt += S[c][1][r]; }
            lsum[c] += ps + pt;
#pragma unroll
            for (int q2 = 0; q2 < 2; ++q2) { const int o = q2 * 8;
                pw[c][q2].x = pk_bf16(S[c][0][o], S[c][0][o + 1]); pw[c][q2].y = pk_bf16(S[c][0][o + 2], S[c][0][o + 3]); pw[c][q2].z = pk_bf16(S[c][0][o + 4], S[c][0][o + 5]); pw[c][q2].w = pk_bf16(S[c][0][o + 6], S[c][0][o + 7]);
                pw[c][2 + q2].x = pk_bf16(S[c][1][o], S[c][1][o + 1]); pw[c][2 + q2].y = pk_bf16(S[c][1][o + 2], S[c][1][o + 3]); pw[c][2 + q2].z = pk_bf16(S[c][1][o + 4], S[c][1][o + 5]); pw[c][2 + q2].w = pk_bf16(S[c][1][o + 6], S[c][1][o + 7]); }
            __builtin_amdgcn_sched_barrier(0);
            if (c == 0) { const unsigned char* vb = lds + so + VOFF + lr * 128;
#pragma unroll
                for (int ksp = 0; ksp < 4; ++ksp) { const int vp = ((ksp * 2 + h) ^ swv) * 16; vf[2 * ksp] = *(const bf16x8*)(vb + vp); vf[2 * ksp + 1] = *(const bf16x8*)(vb + 32 * 128 + vp); }
                __builtin_amdgcn_sched_barrier(0); }
        }
        {
#pragma unroll
          for (int ksp = 0; ksp < 4; ++ksp) {
              const bf16x8 v0 = vf[2 * ksp], v1 = vf[2 * ksp + 1];
              const bf16x8 p0 = __builtin_bit_cast(bf16x8, pw[0][ksp]), p1 = __builtin_bit_cast(bf16x8, pw[1][ksp]);
              O[0][0] = __builtin_amdgcn_mfma_f32_32x32x16_bf16(v0, p0, O[0][0], 0, 0, 0); O[0][1] = __builtin_amdgcn_mfma_f32_32x32x16_bf16(v1, p0, O[0][1], 0, 0, 0);
              O[1][0] = __builtin_amdgcn_mfma_f32_32x32x16_bf16(v0, p1, O[1][0], 0, 0, 0); O[1][1] = __builtin_amdgcn_mfma_f32_32x32x16_bf16(v1, p1, O[1][1], 0, 0, 0); } }
        asm volatile("s_waitcnt vmcnt(0)" ::: "memory");
        __syncthreads();
    }
#undef G2_DMA
    lfin[0] = xhalf_sum(lsum[0]); lfin[1] = xhalf_sum(lsum[1]);
}

__device__ __forceinline__ void store_o(bf16_t* yrow  , const f32x16 (&O)[2], int h) {
#pragma unroll
    for (int mb = 0; mb < 2; ++mb)
#pragma unroll
        for (int q4 = 0; q4 < 4; ++q4) { u32x2 w; w.x = pk_bf16(O[mb][q4 * 4], O[mb][q4 * 4 + 1]); w.y = pk_bf16(O[mb][q4 * 4 + 2], O[mb][q4 * 4 + 3]); *(u32x2*)(yrow + mb * 32 + q4 * 8 + 4 * h) = w; }
}

__device__ __forceinline__ int tok_row(int b, int qrow) { return qrow < SEQ ? b * SEQ + qrow : NLAT + b * CTXL + (qrow - SEQ); }
__device__ __forceinline__ void attn_unit(unsigned char* lds, const Params& p, int l, int type, int b, int head, int qb) {
    const int tid = otid(), lane = tid & 63, wid = tid >> 6, h = lane >> 5, lr = lane & 31;
    const int kt0 = qb < 64 ? 0 : 128, kt1 = 132;
    const int qrow0 = qb * 128 + wid * 32;
    bf16_t* y = p.hbuf + (size_t)tok_row(b, qrow0 + lr) * DM;
    f32x16 O[2]; float lf;
    if (type == 0) {
        const size_t hb = (size_t)(b * 4 + head);
        attn_pipe<96>(lds, p.Qm + (hb * NKEY + qrow0) * 96, p.Km + hb * NKEY * 96, p.VmT + hb * 64 * NKEY, kt0, kt1, O, lf);
        const float inv = 1.f / lf;
#pragma unroll
        for (int r = 0; r < 16; ++r) { O[0][r] *= inv; O[1][r] *= inv; }
        store_o(y + head * 64, O, h);
    } else if (type == 2) {
        const int kt0g = qb < 32 ? 0 : 128, qrow0g = qb * 256 + wid * 64;
        const size_t hq = (size_t)(b * 8 + head), hk = (size_t)(b * 2 + (head >> 2));
        f32x16 O2[2][2]; float lf2[2];
        attn_gqa2(lds, p.Qg + (hq * NKEY + qrow0g) * 64, p.Kg + hk * NKEY * 64, p.VgT + hk * 64 * NKEY, kt0g, kt1, O2, lf2);
#pragma unroll
        for (int c = 0; c < 2; ++c) { const float inv = 1.f / lf2[c];
#pragma unroll
            for (int r = 0; r < 16; ++r) { O2[c][0][r] *= inv; O2[c][1][r] *= inv; }
            store_o(p.hbuf + (size_t)tok_row(b, qrow0g + c * 32 + lr) * DM + 512 + head * 64, O2[c], h); }
    } else {
        f32x16 O1[2];
        const size_t m0 = (size_t)(b * 8 + 2 * head) * NKEY, m1 = m0 + NKEY;
        attn_pipe<32>(lds, p.Qd + (m0 + qrow0) * 32, p.Kd + m0 * 32, p.VdT + (size_t)(b * 4 + head) * 64 * NKEY, kt0, kt1, O1, lf);
        const float inv1 = 1.f / lf;
#pragma unroll
        for (int r = 0; r < 16; ++r) { O1[0][r] *= inv1; O1[1][r] *= inv1; }
        attn_pipe<32>(lds, p.Qd + (m1 + qrow0) * 32, p.Kd + m1 * 32, p.VdT + (size_t)(b * 4 + head) * 64 * NKEY, kt0, kt1, O, lf);
        const float inv2 = p.lam[l] / lf;
        float ss = 0.f;
#pragma unroll
        for (int r = 0; r < 16; ++r) { O[0][r] = O1[0][r] - inv2 * O[0][r]; O[1][r] = O1[1][r] - inv2 * O[1][r]; ss += O[0][r] * O[0][r] + O[1][r] * O[1][r]; }
        ss = xhalf_sum(ss);
        const float lam_init = 0.8f - 0.6f * __expf(-0.3f * (float)l);
        const float rinv = frsq(ss * (1.f / 64.f) + EPS) * (1.f - lam_init);
        const float* g = p.g_diff_sub + l * 64;
#pragma unroll
        for (int mb = 0; mb < 2; ++mb)
#pragma unroll
            for (int q4 = 0; q4 < 4; ++q4) { const f32x4 gv = *(const f32x4*)(g + mb * 32 + q4 * 8 + 4 * h);
#pragma unroll
                for (int e = 0; e < 4; ++e) O[mb][q4 * 4 + e] *= rinv * gv[e]; }
        store_o(y + 256 + head * 64, O, h);
    }
}

__device__ __forceinline__ void attn_phase(unsigned char* lds, const Params& p, int l) {
    __shared__ int s_unit;
    const int qlen = 192 + (l == 0 ? 6 : 0);
    const int xcc = (int)(__builtin_amdgcn_s_getreg((3 << 11) | 20) & 7u);
    for (int xo = 0; xo < 8; ++xo) {
        const int q = (xcc + xo) & 7;
        unsigned* ctr = p.counters + l * 8 + q;
        for (;;) {
            if (otid() == 0) s_unit = (int)atomicAdd(ctr, 1u);
            __syncthreads();
            const int i = s_unit;
            __syncthreads();
            if (i >= qlen) break;
            int type, b, head, qb;
            if (i < 64) { type = 2; b = q >> 2; head = ((q >> 1) & 1) * 4 + (q & 1) * 2 + (i >> 5); qb = i & 31; }
            else if (i < 128) { type = 1; b = q >> 2; head = q & 3; qb = i - 64; }
            else if (i < 192) { type = 0; b = q >> 2; head = q & 3; qb = i - 128; }
            else { const int j = q * 6 + (i - 192);
                if (j < 16) { type = 2; b = j >> 3; head = j & 7; qb = 32; } else if (j < 32) { const int w = j - 16; type = 1; b = w >> 3; head = (w >> 1) & 3; qb = 64 + (w & 1); }
                else { const int w = j - 32; type = 0; b = w >> 3; head = (w >> 1) & 3; qb = 64 + (w & 1); } }
            attn_unit(lds, p, l, type, b, head, qb);
        }
    }
}

__device__ __forceinline__ void norm_store(const f32x4 (&v)[4], float ss, const float* g, const float* sc, const float* sh, bf16_t* hrow, int lane) {
    const float r = frsq(ss * (1.f / 1024.f) + EPS);
#pragma unroll
    for (int i = 0; i < 4; ++i) { const int c = i * 256 + lane * 4; const f32x4 gg = *(const f32x4*)(g + c), s1 = *(const f32x4*)(sc + c), s0 = *(const f32x4*)(sh + c);
        float o[4];
#pragma unroll
        for (int e = 0; e < 4; ++e) o[e] = v[i][e] * r * gg[e] * (1.f + s1[e]) + s0[e];
        u32x2 w; w.x = pk_bf16(o[0], o[1]); w.y = pk_bf16(o[2], o[3]); *(u32x2*)(hrow + c) = w; }
}
__device__ __forceinline__ void phase_prenorm0(const Params& p) {
    const int tid = otid(), lane = tid & 63, gw = blockIdx.x * 4 + (tid >> 6), nw = gridDim.x * 4;
    for (int row = gw; row < NT; row += nw) {
        const float* xr = xin_row(p, 0, row); f32x4 v[4]; float ss = 0.f;
#pragma unroll
        for (int i = 0; i < 4; ++i) { v[i] = *(const f32x4*)(xr + i * 256 + lane * 4); ss += v[i][0] * v[i][0] + v[i][1] * v[i][1] + v[i][2] * v[i][2] + v[i][3] * v[i][3]; }
        ss = wave_sum(ss);
        const float* m = p.mod + (size_t)mod_vec(row) * 6144;
        norm_store(v, ss, p.g_attn_pre, m + 1024, m, p.hbuf + (size_t)row * DM, lane);
    }
}
__device__ __forceinline__ void phase_rowupdate(const Params& p, int l, int which) {
    const int tid = otid(), lane = tid & 63, gw = blockIdx.x * 4 + (tid >> 6), nw = gridDim.x * 4;
    const bool last = l == DEPTH - 1; const int nrows = last ? NLAT : NT;
    for (int row = gw; row < nrows; row += nw) {
        const bf16_t* yr = (const bf16_t*)p.Yf + (size_t)row * DM; const float* xo = which == 0 ? xin_row(p, l, row) : xw_row(p, row); float* xn = xw_row(p, row);
        const float* m = p.mod + (size_t)(l * 3 + mod_vec(row)) * 6144;
        const float* gate = m + (which == 0 ? 2048 : 5120); const float* gp = (which == 0 ? p.g_attn_post : p.g_ffn_post) + l * DM;
        f32x4 y[4], x[4]; float ss = 0.f;
#pragma unroll
        for (int i = 0; i < 4; ++i) { const u32x2 yb = *(const u32x2*)(yr + i * 256 + lane * 4); y[i] = (f32x4){__uint_as_float(yb.x << 16), __uint_as_float(yb.x & 0xffff0000u), __uint_as_float(yb.y << 16), __uint_as_float(yb.y & 0xffff0000u)}; x[i] = *(const f32x4*)(xo + i * 256 + lane * 4); ss += y[i][0] * y[i][0] + y[i][1] * y[i][1] + y[i][2] * y[i][2] + y[i][3] * y[i][3]; }
        ss = wave_sum(ss);
        const float r = frsq(ss * (1.f / 1024.f) + EPS); float s2 = 0.f;
#pragma unroll
        for (int i = 0; i < 4; ++i) { const int c = i * 256 + lane * 4; const f32x4 gt = *(const f32x4*)(gate + c), gg = *(const f32x4*)(gp + c);
#pragma unroll
            for (int e = 0; e < 4; ++e) { x[i][e] += gt[e] * (y[i][e] * r * gg[e]); s2 += x[i][e] * x[i][e]; }
            *(f32x4*)(xn + c) = x[i]; }
        if (which == 0) { s2 = wave_sum(s2); norm_store(x, s2, p.g_ffn_pre + l * DM, m + 4096, m + 3072, p.hbuf + (size_t)row * DM, lane); }
        else if (!last) { s2 = wave_sum(s2); const float* m2 = p.mod + (size_t)((l + 1) * 3 + mod_vec(row)) * 6144; norm_store(x, s2, p.g_attn_pre + (l + 1) * DM, m2 + 1024, m2, p.hbuf + (size_t)row * DM, lane); }
    }
}

__device__ __forceinline__ void conv_tile(unsigned char* lds, const float* __restrict__ src, int K, int N, int kt, int nt, bf16_t* dst, int mode, const float* kscale) {
    float* tile = (float*)lds;
    const int tid = otid(), k0 = kt * 64, n0 = nt * 64;
#pragma unroll 4
    for (int i = 0; i < 16; ++i) { const int k = i * 4 + (tid >> 6), n = tid & 63; float v = 0.f; if (n0 + n < N) { v = src[(size_t)(k0 + k) * N + n0 + n]; if (kscale) v *= kscale[k0 + k]; } tile[k * 65 + n] = v; }
    __syncthreads();
#pragma unroll
    for (int jj = 0; jj < 2; ++jj) { const int c = tid + 256 * jj, n = c >> 3, kc = c & 7, ng = n0 + n;
        if (ng < N) { int row;
            if (mode == 1) row = ng < 384 ? ng : (ng < 416 ? ng + 1536 : ng - 32);
            else if (mode == 2) row = 32 * (ng >> 4) + (ng & 15);
            else if (mode == 3) row = 32 * (ng >> 4) + 16 + (ng & 15);
            else row = ng;
            float e[8];
#pragma unroll
            for (int q = 0; q < 8; ++q) e[q] = tile[(kc * 8 + q) * 65 + n];
            u32x4 w; w.x = pk_bf16(e[0], e[1]); w.y = pk_bf16(e[2], e[3]); w.z = pk_bf16(e[4], e[5]); w.w = pk_bf16(e[6], e[7]);
            *(u32x4*)(dst + (size_t)row * K + k0 + kc * 8) = w; } }
    __syncthreads();
}
__device__ __forceinline__ void sincos_d(double x, float& s, float& c) {
    const double n = rint(x * 0.63661977236758134308);
    double r = x - n * 1.57079632679489655800; r -= n * 6.12323399573676603587e-17;
    const double r2 = r * r;
    double sp = r * (1.0 + r2 * (-1.0 / 6 + r2 * (1.0 / 120 + r2 * (-1.0 / 5040 + r2 * (1.0 / 362880 + r2 * (-1.0 / 39916800 + r2 * (1.0 / 6227020800.0)))))));
    double cp = 1.0 + r2 * (-0.5 + r2 * (1.0 / 24 + r2 * (-1.0 / 720 + r2 * (1.0 / 40320 + r2 * (-1.0 / 3628800 + r2 * (1.0 / 479001600.0))))));
    const int q = ((int)n) & 3;
    const double ss = (q == 0) ? sp : (q == 1) ? cp : (q == 2) ? -sp : -cp;
    const double cc = (q == 0) ? cp : (q == 1) ? -sp : (q == 2) ? -cp : sp;
    s = (float)ss; c = (float)cc;
}
constexpr int CONV_PER_LAYER = 2904, N_CONV = 2 * CONV_PER_LAYER, N_ADA = 192, N_ROPE = 1536, N_PAD = 2;
__device__ __forceinline__ void phase_prologue(unsigned char* lds, const Params& p) {
    const int tid = otid();
    const int total = N_CONV + N_ADA + N_ROPE + N_PAD;
    for (int u = blockIdx.x; u < total; u += gridDim.x) {
        if (u < N_ADA) {
            const int wu = u * 4 + (tid >> 6), lane = tid & 63, l = wu / 384, rem = wu - l * 384, cc = rem >> 4, kc = rem & 15;
            const int col = cc * 256 + lane * 4; f32x4 a0 = {0, 0, 0, 0}, a1 = a0, a2 = a0;
            const float* wbase = p.w_ada + ((size_t)l * 1024 + kc * 64) * 6144 + col;
#pragma unroll 8
            for (int k = 0; k < 64; ++k) { const int kk = kc * 64 + k; const f32x4 w = *(const f32x4*)(wbase + (size_t)k * 6144);
                const float c0 = p.c[kk], c1 = p.c[1024 + kk], c2 = p.c_ctx[kk];
                const float s0 = c0 / (1.f + __expf(-c0)), s1 = c1 / (1.f + __expf(-c1)), s2 = c2 / (1.f + __expf(-c2));
                a0 += w * s0; a1 += w * s1; a2 += w * s2; }
            float* o = p.adapart + ((size_t)(l * 16 + kc) * 3) * 6144 + col;
            *(f32x4*)o = a0; *(f32x4*)(o + 6144) = a1; *(f32x4*)(o + 2 * 6144) = a2;
        } else if (u < N_ADA + N_CONV) {
            const int v = u - N_ADA, l = v / CONV_PER_LAYER, ti = v - l * CONV_PER_LAYER;
            if (ti < 496) conv_tile(lds, p.w_in + (size_t)l * 1024 * 1952, 1024, 1952, ti / 31, ti % 31, p.wt_in + (size_t)l * INW * 1024, 1, nullptr);
            else if (ti < 520) { const int q = ti - 496; conv_tile(lds, p.w_mla_qb + (size_t)l * 256 * 384, 256, 384, q / 6, q % 6, p.wt_qb + (size_t)l * 384 * 256, 0, p.g_mla_q + l * 256); }
            else if (ti < 536) { const int q = ti - 520; conv_tile(lds, p.w_mla_kvb + (size_t)l * 128 * 512, 128, 512, q / 8, q % 8, p.wt_kvb + (size_t)l * 512 * 128, 0, p.g_mla_kv + l * 128); }
            else if (ti < 792) { const int q = ti - 536; conv_tile(lds, p.w_out + (size_t)l * 1024 * 1024, 1024, 1024, q / 16, q % 16, p.wt_out + (size_t)l * 1024 * 1024, 0, nullptr); }
            else if (ti < 1496) { const int q = ti - 792; conv_tile(lds, p.w_gate + (size_t)l * 1024 * FFN, 1024, FFN, q / 44, q % 44, p.wt_gu + (size_t)l * 2 * FFN * 1024, 2, nullptr); }
            else if (ti < 2200) { const int q = ti - 1496; conv_tile(lds, p.w_up + (size_t)l * 1024 * FFN, 1024, FFN, q / 44, q % 44, p.wt_gu + (size_t)l * 2 * FFN * 1024, 3, nullptr); }
            else { const int q = ti - 2200; conv_tile(lds, p.w_down + (size_t)l * FFN * 1024, FFN, 1024, q / 16, q % 16, p.wt_down + (size_t)l * 1024 * FFN, 0, nullptr); }
        } else if (u < N_ADA + N_CONV + N_ROPE) {
            const int e = (u - N_ADA - N_CONV) * 256 + tid, pos = e / 48, a = e - pos * 48;
            const int row = pos >> 6, col = pos & 63;
            if (a < 16) { const float inv = exp2f(-(float)(a & 7) * (13.287712379549449f / 8.f)); const float ang = (float)(a < 8 ? row : col) * inv; float s, c; sincos_d((double)ang, s, c); p.cs16[((size_t)pos * 16 + a) * 2] = c; p.cs16[((size_t)pos * 16 + a) * 2 + 1] = s; }
            else { const int a2 = a - 16; const float inv = exp2f(-(float)(a2 & 15) * (13.287712379549449f / 16.f)); const float ang = (float)(a2 < 16 ? row : col) * inv; float s, c; sincos_d((double)ang, s, c); p.cs32[((size_t)pos * 32 + a2) * 2] = c; p.cs32[((size_t)pos * 32 + a2) * 2 + 1] = s; }
        } else {
            const int l = u - (N_ADA + N_CONV + N_ROPE); u32x4 z = {0, 0, 0, 0}; u32x4* d = (u32x4*)(p.wt_in + ((size_t)l * INW + 1952) * 1024);
            for (int i = tid; i < 96 * 1024 / 8; i += NTHREADS) d[i] = z;
        }
    }
}
__device__ __forceinline__ void phase_adareduce(const Params& p) {
    const int gt = blockIdx.x * NTHREADS + otid(), ntot = gridDim.x * NTHREADS;
    for (int i = gt; i < DEPTH * 3 * 6144; i += ntot) { const int l = i / (3 * 6144), r = i - l * 3 * 6144, v = r / 6144, col = r - v * 6144;
        float s = p.b_ada[l * 6144 + col];
#pragma unroll
        for (int kc = 0; kc < 16; ++kc) s += p.adapart[((size_t)(l * 16 + kc) * 3 + v) * 6144 + col];
        p.mod[i] = s; }
    if (gt < DEPTH) { const int l = gt; float a = 0.f, b = 0.f;
        for (int i = 0; i < 32; ++i) { a += p.lq1[l * 32 + i] * p.lk1[l * 32 + i]; b += p.lq2[l * 32 + i] * p.lk2[l * 32 + i]; }
        p.lam[l] = expf(a) - expf(b) + (0.8f - 0.6f * expf(-0.3f * (float)l)); }
}

#define XB_TMO      128
#define XB_XCNT(j)  (256  + 64 * (j))
#define XB_XSUB(j)  (1280 + 64 * (j))
#define XB_XGEN(j)  (2304 + 64 * (j))
#define XB_TOP      3328
#define XB_TOPGEN   3392
#define XCD_BAR_WORDS 3456
#define XB_SPIN_CAP (1u << 22)
#define LAS __attribute__((address_space(3)))
__device__ __forceinline__ unsigned xb_ld(unsigned* p)              { return __hip_atomic_load(p, __ATOMIC_RELAXED, __HIP_MEMORY_SCOPE_AGENT); }
__device__ __forceinline__ unsigned xb_add(unsigned* p, unsigned v) { return __hip_atomic_fetch_add(p, v, __ATOMIC_RELAXED, __HIP_MEMORY_SCOPE_AGENT); }
__device__ __forceinline__ unsigned xb_xcc_id() { return (unsigned)__builtin_amdgcn_s_getreg((3 << 11) | 20) & 0xFu; }
#define XB_SPIN(cond, bar) do { unsigned _sp = 0; while (cond) { __builtin_amdgcn_s_sleep(1); \
    if ((++_sp & 255u) == 0u) { if (xb_ld(&(bar)[XB_TMO])) break; if (_sp > XB_SPIN_CAP) { atomicAdd(&(bar)[XB_TMO], 1u); break; } } } } while (0)
struct XcdBarrier { unsigned* bar; unsigned x; volatile LAS unsigned* st; };
__device__ __forceinline__ XcdBarrier xcd_barrier_post(unsigned* bar, volatile LAS unsigned* st) {
    XcdBarrier b; b.bar = bar; b.x = xb_xcc_id(); b.st = st;
    if (threadIdx.x == 0) (void)xb_add(&bar[XB_XCNT(b.x)], 1u);
    return b;
}
__device__ __forceinline__ void xcd_barrier_complete(unsigned* bar, unsigned x, unsigned& nloc, unsigned& nx) {
    const unsigned G = gridDim.x * gridDim.y * gridDim.z;
    unsigned sum, cnt, mine, sp = 0u;
    for (;;) {
        sum = 0u; cnt = 0u; mine = 0u;
#pragma unroll
        for (unsigned j = 0; j < 16; ++j) { const unsigned c = xb_ld(&bar[XB_XCNT(j)]); sum += c; cnt += (c > 0u) ? 1u : 0u; mine = (j == x) ? c : mine; }
        if (sum == G) break;
        __builtin_amdgcn_s_sleep(1);
        if ((++sp & 255u) == 0u) { if (xb_ld(&bar[XB_TMO])) break; if (sp > XB_SPIN_CAP) { atomicAdd(&bar[XB_TMO], 1u); break; } }
    }
    nloc = mine > 0u ? mine : 1u; nx = cnt > 0u ? cnt : 1u;
}
__device__ __forceinline__ void xcd_barrier(const XcdBarrier& b) {
    asm volatile("s_waitcnt vmcnt(0)" ::: "memory");
    __syncthreads();
    if (threadIdx.x == 0) {
        unsigned* bar = b.bar;
        __builtin_amdgcn_s_waitcnt(0);
        unsigned nloc = b.st[0], nx = b.st[1];
        if (nloc == 0u) { xcd_barrier_complete(bar, b.x, nloc, nx); b.st[0] = nloc; b.st[1] = nx; }
        const unsigned old = xb_add(&bar[XB_XSUB(b.x)], 1u);
        const unsigned gen = old / nloc;
        if (old + 1u == (gen + 1u) * nloc) {
            __builtin_amdgcn_fence(__ATOMIC_RELEASE, "agent");
            asm volatile("s_waitcnt vmcnt(0)" ::: "memory");
            const unsigned og = xb_add(&bar[XB_TOP], 1u);
            const unsigned tg = og / nx;
            if (og + 1u == (tg + 1u) * nx) xb_add(&bar[XB_TOPGEN], 1u);
            else XB_SPIN(xb_ld(&bar[XB_TOPGEN]) == tg, bar);
            __builtin_amdgcn_fence(__ATOMIC_ACQUIRE, "agent");
            xb_add(&bar[XB_XGEN(b.x)], 1u);
            asm volatile("s_waitcnt vmcnt(0)" ::: "memory");
        } else {
            XB_SPIN(xb_ld(&bar[XB_XGEN(b.x)]) == gen, bar);
            __builtin_amdgcn_fence(__ATOMIC_ACQUIRE, "agent");
            asm volatile("s_waitcnt vmcnt(0)" ::: "memory");
        }
    }
    __syncthreads();
}

__device__ __forceinline__ void simple_barrier(unsigned* cnt, unsigned target) {
    asm volatile("s_waitcnt vmcnt(0)" ::: "memory");
    __syncthreads();
    if (threadIdx.x == 0) {
        __builtin_amdgcn_fence(__ATOMIC_RELEASE, "agent");
        asm volatile("s_waitcnt vmcnt(0)" ::: "memory");
        (void)__hip_atomic_fetch_add(cnt, 1u, __ATOMIC_RELAXED, __HIP_MEMORY_SCOPE_AGENT);
        unsigned sp = 0;
        while (__hip_atomic_load(cnt, __ATOMIC_RELAXED, __HIP_MEMORY_SCOPE_AGENT) < target) { __builtin_amdgcn_s_sleep(2); if (++sp > (1u << 24)) break; }
        __builtin_amdgcn_fence(__ATOMIC_ACQUIRE, "agent");
        asm volatile("s_waitcnt vmcnt(0)" ::: "memory");
    }
    __syncthreads();
}

constexpr int N_PHASES = 3 + 8 * DEPTH;
__global__ void __launch_bounds__(NTHREADS, 2) fwd_kernel(Params p) {
    extern __shared__ __attribute__((aligned(16))) unsigned char lds[];
    __shared__ uint4 xb_words;
    if (threadIdx.x == 0) xb_words = make_uint4(0u, 0u, 0u, 0u);
    __syncthreads();
    XcdBarrier xb = xcd_barrier_post(p.counters + 64, (volatile LAS unsigned*)&xb_words);
    for (int ph = p.phase_begin; ph < p.phase_end; ++ph) {
        if (ph == 0) phase_prologue(lds, p);
        else if (ph == 1) phase_adareduce(p);
        else if (ph == 2) phase_prenorm0(p);
        else {
            const int l = (ph - 3) >> 3, s = (ph - 3) & 7; const bool last = l == DEPTH - 1;
            if (s == 0) { EpiInProj e{&p, l}; gemm_phase(lds, p.wt_in + (size_t)l * INW * 1024, 1024, p.hbuf, DM, 1024, NT / 128, INW / 128, e); }
            else if (s == 1) {
                EpiMlaQ eq{&p}; EpiMlaKV ek{&p};
                const int nq = 136 * 3, nkv = 136 * 4;
                for (int u = blockIdx.x; u < nq + nkv; u += gridDim.x) { int tt, nt;
                    if (u < nq) { if (gemm_unit(u, NT / 128, 3, tt, nt)) gemm_tile(lds, p.wt_qb + (size_t)l * 384 * 256, 256, p.qkva, 384, 256, nt * 128, tt * 128, eq); }
                    else { if (gemm_unit(u - nq, NT / 128, 4, tt, nt)) gemm_tile(lds, p.wt_kvb + (size_t)l * 512 * 128, 128, p.qkva + 256, 384, 128, nt * 128, tt * 128, ek); } }
            }
            else if (s == 2) attn_phase(lds, p, l);
            else if (s == 3) gemm_phase_n1024(lds, p.wt_out + (size_t)l * 1024 * 1024, 1024, p.hbuf, DM, 1024, !last, (bf16_t*)p.Yf);
            else if (s == 4) phase_rowupdate(p, l, 0);
            else if (s == 5) { EpiSwiglu e{p.Gact}; gemm_phase(lds, p.wt_gu + (size_t)l * 2 * FFN * 1024, 1024, p.hbuf, DM, 1024, (last ? NLAT : NT) / 128, 44, e); }
            else if (s == 6) gemm_phase_n1024(lds, p.wt_down + (size_t)l * 1024 * FFN, FFN, p.Gact, FFN, FFN, !last, (bf16_t*)p.Yf);
            else phase_rowupdate(p, l, 1);
        }
        if (ph + 1 < p.phase_end) { if (p.coop == 1) xcd_barrier(xb); else if (p.coop == 3) simple_barrier(p.counters + 32, (unsigned)(ph - p.phase_begin + 1) * gridDim.x); else if (p.coop == 2) cg::this_grid().sync(); }
    }
}

extern "C" void kernel_launch(void* const* d_in, const int* in_sizes, int n_in, void* d_out, int out_size, void* d_ws, size_t ws_size, hipStream_t stream) {
    static int grid = 0;
    if (grid == 0) {
        int dev = 0, cus = 0, per_cu = 0;
        hipGetDevice(&dev); hipDeviceGetAttribute(&cus, hipDeviceAttributeMultiprocessorCount, dev);
        hipFuncSetAttribute((const void*)fwd_kernel, hipFuncAttributeMaxDynamicSharedMemorySize, LDS_BYTES);
        hipOccupancyMaxActiveBlocksPerMultiprocessor(&per_cu, (const void*)fwd_kernel, NTHREADS, LDS_BYTES);
        per_cu = 2;
        grid = cus * per_cu;
        fprintf(stderr, "kernel_launch: cus %d per_cu %d grid %d ws %zu\n", cus, per_cu, grid, ws_size);
    }
    Params p{};
    { const float* inp[26]; for (int i = 0; i < 26; ++i) inp[i] = (const float*)d_in[i]; memcpy((void*)&p, inp, sizeof(inp)); }
    p.out = (float*)d_out;
    unsigned char* w = (unsigned char*)d_ws; size_t off = 0;
    auto take = [&](size_t bytes) { unsigned char* r = w + off; off += (bytes + 255) & ~(size_t)255; return r; };
    p.counters = (unsigned*)take(256 + XCD_BAR_WORDS * 4);
    p.wt_in = (bf16_t*)take((size_t)2 * INW * 1024 * 2);
    p.wt_qb = (bf16_t*)take((size_t)2 * 384 * 256 * 2);
    p.wt_kvb = (bf16_t*)take((size_t)2 * 512 * 128 * 2);
    p.wt_out = (bf16_t*)take((size_t)2 * 1024 * 1024 * 2);
    p.wt_gu = (bf16_t*)take((size_t)2 * 2 * FFN * 1024 * 2);
    p.wt_down = (bf16_t*)take((size_t)2 * 1024 * FFN * 2);
    p.adapart = (float*)take((size_t)2 * 16 * 3 * 6144 * 4);
    p.mod = (float*)take((size_t)2 * 3 * 6144 * 4);
    p.lam = (float*)take(256);
    p.cs16 = (float*)take((size_t)SEQ * 16 * 2 * 4);
    p.cs32 = (float*)take((size_t)SEQ * 32 * 2 * 4);
    p.xc = (float*)take((size_t)NB * CTXL * DM * 4);
    p.ssq = (float*)take((size_t)NT * 8 * 4);
    p.hbuf = (bf16_t*)take((size_t)NT * DM * 2);
    p.Yf = (float*)take((size_t)NT * DM * 4); p.qkva = (bf16_t*)p.Yf;
    unsigned char* ra = take((size_t)NT * FFN * 2); p.Gact = (bf16_t*)ra;
    { size_t o2 = 0; auto tk = [&](size_t bytes) { unsigned char* r = ra + o2; o2 += (bytes + 255) & ~(size_t)255; return (bf16_t*)r; };
      p.Qm = tk((size_t)NB * 4 * NKEY * 96 * 2); p.Km = tk((size_t)NB * 4 * NKEY * 96 * 2); p.VmT = tk((size_t)NB * 4 * 64 * NKEY * 2);
      p.Qd = tk((size_t)NB * 8 * NKEY * 32 * 2); p.Kd = tk((size_t)NB * 8 * NKEY * 32 * 2); p.VdT = tk((size_t)NB * 4 * 64 * NKEY * 2);
      p.Qg = tk((size_t)NB * 8 * NKEY * 64 * 2); p.Kg = tk((size_t)NB * 2 * NKEY * 64 * 2); p.VgT = tk((size_t)NB * 2 * 64 * NKEY * 2);
      if (o2 > (size_t)NT * FFN * 2) { fprintf(stderr, "kernel_launch: region RA overflow\n"); return; } }
    if (off > ws_size) { fprintf(stderr, "kernel_launch: workspace too small: need %zu have %zu\n", off, ws_size); return; }
    (void)hipMemsetAsync(p.counters, 0, 256 + XCD_BAR_WORDS * 4, stream);
#if ONE_LAUNCH
    p.phase_begin = 0; p.phase_end = N_PHASES; p.coop = 1;
    void* args[] = {&p};
    hipError_t e = hipLaunchCooperativeKernel((const void*)fwd_kernel, dim3(grid), dim3(NTHREADS), args, LDS_BYTES, stream);
    if (e != hipSuccess) fprintf(stderr, "cooperative launch failed: %s (grid %d)\n", hipGetErrorString(e), grid);
#else
    for (int ph = 0; ph < N_PHASES; ++ph) { p.phase_begin = ph; p.phase_end = ph + 1; p.coop = 0; hipLaunchKernelGGL(fwd_kernel, dim3(grid), dim3(NTHREADS), LDS_BYTES, stream, p); }
#endif
}
```

```cpp
#include <hip/hip_runtime.h>
#include <hip/hip_cooperative_groups.h>
#include <stdint.h>
#include <stdio.h>
#include <string.h>
namespace cg = cooperative_groups;

#ifndef ONE_LAUNCH
#define ONE_LAUNCH 1
#endif

typedef unsigned short bf16_t;
typedef short bf16x8 __attribute__((ext_vector_type(8)));
typedef float f32x16 __attribute__((ext_vector_type(16)));
typedef float f32x4 __attribute__((ext_vector_type(4)));
typedef float f32x2 __attribute__((ext_vector_type(2)));
typedef unsigned u32x4 __attribute__((ext_vector_type(4)));
typedef unsigned u32x2 __attribute__((ext_vector_type(2)));

constexpr int DM = 1024, NB = 2, SEQ = 8192, CTXL = 256, NKEY = SEQ + CTXL, NLAT = NB * SEQ, NT = NLAT + NB * CTXL;
constexpr int FFN = 2816, INW = 2048, DEPTH = 2;
constexpr float EPS = 1e-6f, LOG2E = 1.4426950408889634f;
constexpr float MLA_SC = 0.10206207261596577f * LOG2E, DIFF_SC = 0.17677669529663687f * LOG2E, GQA_SC = 0.125f * LOG2E;
constexpr int LDS_BYTES = 73728;
constexpr int NTHREADS = 256;

struct Params {
    const float *x, *c, *ctx, *c_ctx, *w_ada, *b_ada, *g_attn_pre, *g_attn_post, *w_in, *g_mla_q, *w_mla_qb, *g_mla_kv, *w_mla_kvb,
        *lq1, *lk1, *lq2, *lk2, *g_diff_sub, *g_gqa_q, *g_gqa_k, *w_out, *g_ffn_pre, *g_ffn_post, *w_gate, *w_up, *w_down;
    float* out;
    bf16_t *wt_in, *wt_qb, *wt_kvb, *wt_out, *wt_gu, *wt_down;
    float *adapart, *mod, *lam, *cs16, *cs32, *xc, *ssq, *Yf;
    bf16_t *hbuf, *qkva, *Qm, *Km, *VmT, *Qd, *Kd, *VdT, *Qg, *Kg, *VgT, *Gact;
    unsigned* counters;
    int phase_begin, phase_end, coop, pad;
};

typedef __bf16 bf16x2_t __attribute__((ext_vector_type(2)));
__device__ __forceinline__ unsigned pk_bf16(float lo, float hi) { const f32x2 v = {lo, hi}; const bf16x2_t b = __builtin_convertvector(v, bf16x2_t); return __builtin_bit_cast(unsigned, b); }
__device__ __forceinline__ int otid() { int t = threadIdx.x; asm volatile("" : "+v"(t)); return t; }
__device__ __forceinline__ float fexp2(float x) { return __builtin_amdgcn_exp2f(x); }
__device__ __forceinline__ float max3f(float a, float b, float c) { float r; asm("v_max3_f32 %0, %1, %2, %3" : "=v"(r) : "v"(a), "v"(b), "v"(c)); return r; }
__device__ __forceinline__ float xhalf_max(float x) { return fmaxf(x, __shfl_xor(x, 32)); }
__device__ __forceinline__ float xhalf_sum(float x) { return x + __shfl_xor(x, 32); }
__device__ __forceinline__ float frsq(float x) { return __builtin_amdgcn_rsqf(x); }
__device__ __forceinline__ float wave_sum(float v) {
#pragma unroll
    for (int o = 32; o >= 1; o >>= 1) v += __shfl_xor(v, o);
    return v;
}
__device__ __forceinline__ void tok_decode(int t, int& b, int& j) { if (t < NLAT) { b = t >> 13; j = t & (SEQ - 1); } else { const int c = t - NLAT; b = c >> 8; j = SEQ + (c & (CTXL - 1)); } }
__device__ __forceinline__ const float* xin_row(const Params& p, int l, int t) {
    if (l == 0) return t < NLAT ? p.x + (size_t)t * DM : p.ctx + (size_t)(t - NLAT) * DM;
    return t < NLAT ? p.out + (size_t)t * DM : p.xc + (size_t)(t - NLAT) * DM;
}
__device__ __forceinline__ float* xw_row(const Params& p, int t) { return t < NLAT ? p.out + (size_t)t * DM : p.xc + (size_t)(t - NLAT) * DM; }
__device__ __forceinline__ int mod_vec(int t) { return t < NLAT ? (t >> 13) : 2; }

#define LASP __attribute__((address_space(3)))
typedef float f32x4acc __attribute__((ext_vector_type(4)));
template <class Epi>
__device__ __forceinline__ void gemm_tile(unsigned char* lds, const bf16_t* __restrict__ W, int ldw, const bf16_t* __restrict__ A, int lda, int K, int n0, int t0, const Epi& epi) {
    const int tid = otid(), lane = tid & 63, wid = tid >> 6, wn = wid >> 1, wt = wid & 1;
    const int dr = lane >> 3, dp = lane & 7;
    unsigned woff[4], aoff[4];
#pragma unroll
    for (int j = 0; j < 4; ++j) { const int row = (wid * 4 + j) * 8 + dr, c = dp ^ ((row >> 1) & 7);
        woff[j] = (unsigned)((n0 + row) * ldw + c * 8); aoff[j] = (unsigned)((t0 + row) * lda + c * 8); }
    const unsigned lbase = (unsigned)(size_t)lds + (unsigned)wid * 4096u;
    f32x4 acc[4][4];
#pragma unroll
    for (int a = 0; a < 4; ++a)
#pragma unroll
        for (int b = 0; b < 4; ++b) acc[a][b] = (f32x4){0.f, 0.f, 0.f, 0.f};
#define GT_DMA(kt_, st_) do { _Pragma("unroll") for (int j = 0; j < 4; ++j) { \
        __builtin_amdgcn_global_load_lds((const unsigned*)(W + woff[j] + (size_t)(kt_) * 64), (LASP unsigned*)(lbase + (unsigned)(st_) * 32768u + (unsigned)j * 1024u), 16, 0, 0); \
        __builtin_amdgcn_global_load_lds((const unsigned*)(A + aoff[j] + (size_t)(kt_) * 64), (LASP unsigned*)(lbase + (unsigned)(st_) * 32768u + 16384u + (unsigned)j * 1024u), 16, 0, 0); } } while (0)
    const int r16 = lane & 15, q = lane >> 4, sw = r16 >> 1;
    const int base_w = (wn * 64 + r16) * 128, base_a = 16384 + (wt * 64 + r16) * 128;
    const int nk = K >> 6;
    GT_DMA(0, 0);
    asm volatile("s_waitcnt vmcnt(0)" ::: "memory");
    __syncthreads();
    for (int kt = 0; kt < nk; ++kt) {
        const int st = kt & 1;
        if (kt + 1 < nk) GT_DMA(kt + 1, st ^ 1);
        const unsigned char* sb = lds + st * 32768;
#pragma unroll
        for (int ks = 0; ks < 2; ++ks) {
            const int pos = ((ks * 4 + q) ^ sw) * 16;
            bf16x8 fa[4], fb[4];
#pragma unroll
            for (int i = 0; i < 4; ++i) { fa[i] = *(const bf16x8*)(sb + base_w + i * 2048 + pos); fb[i] = *(const bf16x8*)(sb + base_a + i * 2048 + pos); }
#pragma unroll
            for (int ni = 0; ni < 4; ++ni)
#pragma unroll
                for (int ti = 0; ti < 4; ++ti) acc[ni][ti] = __builtin_amdgcn_mfma_f32_16x16x32_bf16(fa[ni], fb[ti], acc[ni][ti], 0, 0, 0);
            __builtin_amdgcn_sched_group_barrier(0x100, 8, 0);
            __builtin_amdgcn_sched_group_barrier(0x008, 16, 0);
        }
        asm volatile("s_waitcnt vmcnt(0)" ::: "memory");
        __syncthreads();
    }
#undef GT_DMA
    epi(acc, n0 + wn * 64, t0 + wt * 64, lane);
}

__device__ __forceinline__ bool gemm_unit(int u, int ntt, int nn, int& tt, int& nt) {
    const int xcd = u & 7, v = u >> 3; nt = v % nn; tt = (v / nn) * 8 + xcd; return tt < ntt;
}
__device__ __forceinline__ void store4(bf16_t* dst, const f32x4& v);
__device__ __forceinline__ void gemm_tile_small(unsigned char* lds, const bf16_t* __restrict__ W, int ldw, const bf16_t* __restrict__ A, int lda, int K, int n0, int t0, bf16_t* O, int ldo) {
    const int tid = otid(), lane = tid & 63, wid = tid >> 6;
    const int dr = lane >> 3, dp = lane & 7;
    unsigned woff[4], aoff;
#pragma unroll
    for (int j = 0; j < 4; ++j) { const int row = (wid * 4 + j) * 8 + dr, c = dp ^ ((row >> 1) & 7); woff[j] = (unsigned)((n0 + row) * ldw + c * 8); }
    { const int row = wid * 8 + dr, c = dp ^ ((row >> 1) & 7); aoff = (unsigned)((t0 + row) * lda + c * 8); }
    const unsigned lbase = (unsigned)(size_t)lds;
    f32x4 acc[2][2];
#pragma unroll
    for (int a = 0; a < 2; ++a) { acc[a][0] = (f32x4){0.f, 0.f, 0.f, 0.f}; acc[a][1] = (f32x4){0.f, 0.f, 0.f, 0.f}; }
#define GS_DMA(kt_, st_) do { _Pragma("unroll") for (int j = 0; j < 4; ++j) \
        __builtin_amdgcn_global_load_lds((const unsigned*)(W + woff[j] + (size_t)(kt_) * 64), (LASP unsigned*)(lbase + (unsigned)(st_) * 32768u + (unsigned)wid * 4096u + (unsigned)j * 1024u), 16, 0, 0); \
        __builtin_amdgcn_global_load_lds((const unsigned*)(A + aoff + (size_t)(kt_) * 64), (LASP unsigned*)(lbase + (unsigned)(st_) * 32768u + 16384u + (unsigned)wid * 1024u), 16, 0, 0); } while (0)
    const int r16 = lane & 15, q = lane >> 4, sw = r16 >> 1;
    const int base_w = (wid * 32 + r16) * 128, base_a = 16384 + r16 * 128;
    const int nk = K >> 6;
    GS_DMA(0, 0);
    asm volatile("s_waitcnt vmcnt(0)" ::: "memory");
    __syncthreads();
    for (int kt = 0; kt < nk; ++kt) {
        const int st = kt & 1;
        if (kt + 1 < nk) GS_DMA(kt + 1, st ^ 1);
        const unsigned char* sb = lds + st * 32768;
#pragma unroll
        for (int ks = 0; ks < 2; ++ks) {
            const int pos = ((ks * 4 + q) ^ sw) * 16;
            bf16x8 fa[2], fb[2];
#pragma unroll
            for (int i = 0; i < 2; ++i) { fa[i] = *(const bf16x8*)(sb + base_w + i * 2048 + pos); fb[i] = *(const bf16x8*)(sb + base_a + i * 2048 + pos); }
#pragma unroll
            for (int ni = 0; ni < 2; ++ni)
#pragma unroll
                for (int ti = 0; ti < 2; ++ti) acc[ni][ti] = __builtin_amdgcn_mfma_f32_16x16x32_bf16(fa[ni], fb[ti], acc[ni][ti], 0, 0, 0);
        }
        asm volatile("s_waitcnt vmcnt(0)" ::: "memory");
        __syncthreads();
    }
#undef GS_DMA
#pragma unroll
    for (int ti = 0; ti < 2; ++ti) { bf16_t* row = O + (size_t)(t0 + ti * 16 + r16) * ldo + n0 + wid * 32 + 4 * q;
#pragma unroll
        for (int ni = 0; ni < 2; ++ni) store4(row + ni * 16, acc[ni][ti]); }
}
__device__ __forceinline__ void gemm_phase_n1024(unsigned char* lds, const bf16_t* W, int ldw, const bf16_t* A, int lda, int K, bool with_ctx, bf16_t* O);

template <class Epi>
__device__ __forceinline__ void gemm_phase(unsigned char* lds, const bf16_t* W, int ldw, const bf16_t* A, int lda, int K, int ntt, int nn, const Epi& epi) {
    const int x = blockIdx.x & 7, j = blockIdx.x >> 3, stride = gridDim.x >> 3;
    const int ntx = (ntt - x + 7) >> 3;
    const int total = ntx * nn;
    for (int i = j; i < total; i += stride) {
        int tg = 0, rem = i;
        for (;;) { const int tc = min(8, ntx - 8 * tg); if (rem < tc * nn) break; rem -= tc * nn; ++tg; }
        const int tc = min(8, ntx - 8 * tg);
        const int ng = rem / (tc * 8), r2 = rem - ng * tc * 8;
        const int nl = r2 / tc, tl = r2 - nl * tc;
        const int nt = ng * 8 + nl, tt = (tg * 8 + tl) * 8 + x;
        gemm_tile(lds, W, ldw, A, lda, K, nt * 128, tt * 128, epi);
    }
}

__device__ __forceinline__ void store4(bf16_t* dst, const f32x4& v) { u32x2 w; w.x = pk_bf16(v[0], v[1]); w.y = pk_bf16(v[2], v[3]); *(u32x2*)dst = w; }
__device__ __forceinline__ float quad_sum(float v) { v += __shfl_xor(v, 16); v += __shfl_xor(v, 32); return v; }
__device__ __forceinline__ float sumsq4(const f32x4& v) { return v[0] * v[0] + v[1] * v[1] + v[2] * v[2] + v[3] * v[3]; }
__device__ __forceinline__ void rope4(f32x4& x1, f32x4& x2, const float* cs) {
    const f32x4 c01 = *(const f32x4*)cs, c23 = *(const f32x4*)(cs + 4);
    const f32x4 cc = {c01[0], c01[2], c23[0], c23[2]}, sn = {c01[1], c01[3], c23[1], c23[3]};
    const f32x4 a = x1 * cc - x2 * sn, b = x2 * cc + x1 * sn; x1 = a; x2 = b;
}

struct EpiInProj {
    const Params* pp; int l;
    __device__ __forceinline__ void operator()(f32x4 (&acc)[4][4], int nb0, int tb0, int lane) const {
        const Params& p = *pp; const int q = lane >> 4, r16 = lane & 15;
#pragma unroll
        for (int ti = 0; ti < 4; ++ti) {
            const int t = tb0 + ti * 16 + r16; int b, j; tok_decode(t, b, j); const bool lat = j < SEQ;
            if (nb0 < 384) {
                float ss = 0.f;
#pragma unroll
                for (int ni = 0; ni < 4; ++ni) { ss += sumsq4(acc[ni][ti]); store4(p.qkva + (size_t)t * 384 + nb0 + ni * 16 + 4 * q, acc[ni][ti]); }
                ss = quad_sum(ss);
                if (q == 0) p.ssq[(size_t)t * 8 + (nb0 >> 6)] = ss;
            } else if (nb0 < 896) {
                const bool isq = nb0 < 640;
#pragma unroll
                for (int mp = 0; mp < 2; ++mp) { f32x4 x1 = acc[2 * mp][ti], x2 = acc[2 * mp + 1][ti];
                    if (lat) rope4(x1, x2, p.cs16 + ((size_t)j * 16 + 4 * q) * 2);
                    if (isq) { x1 *= DIFF_SC; x2 *= DIFF_SC; }
                    const int map = ((nb0 - (isq ? 384 : 640)) >> 5) + mp;
                    bf16_t* dst = (isq ? p.Qd : p.Kd) + ((size_t)(b * 8 + map) * NKEY + j) * 32 + 4 * q;
                    store4(dst, x1); store4(dst + 16, x2); }
            } else if (nb0 < 1152 || (nb0 >= 1792 && nb0 < 1920)) {
                const bool isd = nb0 < 1152; const int hd = isd ? (nb0 - 896) >> 6 : (nb0 - 1792) >> 6;
                bf16_t* base = (isd ? p.VdT + (size_t)(b * 4 + hd) * 64 * NKEY : p.VgT + (size_t)(b * 2 + hd) * 64 * NKEY) + j;
#pragma unroll
                for (int ni = 0; ni < 4; ++ni)
#pragma unroll
                    for (int e = 0; e < 4; ++e) base[(size_t)(ni * 16 + 4 * q + e) * NKEY] = (bf16_t)(pk_bf16(acc[ni][ti][e], 0.f) & 0xffffu);
            } else if (nb0 < 1792) {
                const bool isq = nb0 < 1664; const int head = isq ? (nb0 - 1152) >> 6 : (nb0 - 1664) >> 6;
                const float* g = (isq ? p.g_gqa_q : p.g_gqa_k) + l * 64;
                float ss = 0.f;
#pragma unroll
                for (int ni = 0; ni < 4; ++ni) ss += sumsq4(acc[ni][ti]);
                ss = quad_sum(ss);
                const float rinv = frsq(ss * (1.f / 64.f) + EPS);
                bf16_t* dst = (isq ? p.Qg + ((size_t)(b * 8 + head) * NKEY + j) * 64 : p.Kg + ((size_t)(b * 2 + head) * NKEY + j) * 64);
#pragma unroll
                for (int mp = 0; mp < 2; ++mp) { const int d0 = mp * 16 + 4 * q;
                    f32x4 x1 = acc[mp][ti] * rinv * *(const f32x4*)(g + d0), x2 = acc[mp + 2][ti] * rinv * *(const f32x4*)(g + 32 + d0);
                    if (lat) rope4(x1, x2, p.cs32 + ((size_t)j * 32 + d0) * 2);
                    if (isq) { x1 *= GQA_SC; x2 *= GQA_SC; }
                    store4(dst + d0, x1); store4(dst + 32 + d0, x2); }
            } else if (nb0 == 1920) {
                f32x4 x1 = acc[0][ti], x2 = acc[1][ti];
                if (lat) rope4(x1, x2, p.cs16 + ((size_t)j * 16 + 4 * q) * 2);
#pragma unroll
                for (int hh = 0; hh < 4; ++hh) { bf16_t* dst = p.Km + ((size_t)(b * 4 + hh) * NKEY + j) * 96 + 64 + 4 * q; store4(dst, x1); store4(dst + 16, x2); }
            }
        }
    }
};

struct EpiMlaQ {
    const Params* pp;
    __device__ __forceinline__ void operator()(f32x4 (&acc)[4][4], int nb0, int tb0, int lane) const {
        const Params& p = *pp; const int q = lane >> 4, r16 = lane & 15;
#pragma unroll
        for (int ti = 0; ti < 4; ++ti) {
            const int t = tb0 + ti * 16 + r16; int b, j; tok_decode(t, b, j); const bool lat = j < SEQ;
            const f32x4 s4 = *(const f32x4*)(p.ssq + (size_t)t * 8);
            const float rq = frsq((s4[0] + s4[1] + s4[2] + s4[3]) * (1.f / 256.f) + EPS) * MLA_SC;
#pragma unroll
            for (int ni = 0; ni < 4; ++ni) {
                const int k16 = (nb0 >> 4) + ni, head = k16 / 6, part = k16 - head * 6;
                bf16_t* dst = p.Qm + ((size_t)(b * 4 + head) * NKEY + j) * 96 + part * 16 + 4 * q;
                if (part < 4) store4(dst, acc[ni][ti] * rq);
                else if (part == 4) { if (ni < 3) { f32x4 x1 = acc[ni][ti] * rq, x2 = acc[ni < 3 ? ni + 1 : ni][ti] * rq;
                    if (lat) rope4(x1, x2, p.cs16 + ((size_t)j * 16 + 4 * q) * 2);
                    store4(dst, x1); store4(dst + 16, x2); } }
            }
        }
    }
};
struct EpiMlaKV {
    const Params* pp;
    __device__ __forceinline__ void operator()(f32x4 (&acc)[4][4], int nb0, int tb0, int lane) const {
        const Params& p = *pp; const int q = lane >> 4, r16 = lane & 15;
        const int head = nb0 >> 7; const bool isv = (nb0 & 64) != 0;
#pragma unroll
        for (int ti = 0; ti < 4; ++ti) {
            const int t = tb0 + ti * 16 + r16; int b, j; tok_decode(t, b, j);
            const float rkv = frsq((p.ssq[(size_t)t * 8 + 4] + p.ssq[(size_t)t * 8 + 5]) * (1.f / 128.f) + EPS);
#pragma unroll
            for (int ni = 0; ni < 4; ++ni) {
                if (!isv) store4(p.Km + ((size_t)(b * 4 + head) * NKEY + j) * 96 + ni * 16 + 4 * q, acc[ni][ti] * rkv);
                else { bf16_t* base = p.VmT + (size_t)(b * 4 + head) * 64 * NKEY + j;
#pragma unroll
                    for (int e = 0; e < 4; ++e) base[(size_t)(ni * 16 + 4 * q + e) * NKEY] = (bf16_t)(pk_bf16(acc[ni][ti][e] * rkv, 0.f) & 0xffffu); }
            }
        }
    }
};
struct EpiBf16Out {
    bf16_t* O; int ldo;
    __device__ __forceinline__ void operator()(f32x4 (&acc)[4][4], int nb0, int tb0, int lane) const {
        const int q = lane >> 4, r16 = lane & 15;
#pragma unroll
        for (int ti = 0; ti < 4; ++ti) { bf16_t* row = O + (size_t)(tb0 + ti * 16 + r16) * ldo + nb0 + 4 * q;
#pragma unroll
            for (int ni = 0; ni < 4; ++ni) store4(row + ni * 16, acc[ni][ti]); }
    }
};
__device__ __forceinline__ void gemm_phase_n1024(unsigned char* lds, const bf16_t* W, int ldw, const bf16_t* A, int lda, int K, bool with_ctx, bf16_t* O) {
    EpiBf16Out e{O, DM};
    gemm_phase(lds, W, ldw, A, lda, K, NLAT / 128, 8, e);
    if (with_ctx) {
        if (gridDim.x == 512) {
            if (((blockIdx.x >> 3) & 3) == 0) { const int u = (blockIdx.x >> 5) * 8 + (blockIdx.x & 7); gemm_tile_small(lds, W, ldw, A, lda, K, (u & 7) * 128, NLAT + (u >> 3) * 32, O, DM); }
        } else for (int u = blockIdx.x; u < 128; u += gridDim.x) gemm_tile_small(lds, W, ldw, A, lda, K, (u & 7) * 128, NLAT + (u >> 3) * 32, O, DM);
    }
}
struct EpiSwiglu {
    bf16_t* G;
    __device__ __forceinline__ void operator()(f32x4 (&acc)[4][4], int nb0, int tb0, int lane) const {
        const int q = lane >> 4, r16 = lane & 15;
#pragma unroll
        for (int ti = 0; ti < 4; ++ti) { bf16_t* row = G + (size_t)(tb0 + ti * 16 + r16) * FFN + ((nb0 >> 5) * 16) + 4 * q;
#pragma unroll
            for (int mp = 0; mp < 2; ++mp) { f32x4 a;
#pragma unroll
                for (int e = 0; e < 4; ++e) { const float g = acc[2 * mp][ti][e], u = acc[2 * mp + 1][ti][e]; a[e] = g * __builtin_amdgcn_rcpf(1.f + fexp2(-g * LOG2E)) * u; }
                store4(row + mp * 16, a); } }
    }
};

template <int DQK>
__device__ __forceinline__ void attn_pipe(unsigned char* lds, const bf16_t* __restrict__ Qw, const bf16_t* __restrict__ Kh, const bf16_t* __restrict__ VTh, int kt0, int kt1, f32x16 (&O)[2], float& lfin) {
    constexpr int KMAIN = DQK >= 64 ? 8192 : 4096, KROPE = DQK == 96 ? 4096 : 0, VOFF = KMAIN + KROPE, STG = VOFF + 8192;
    constexpr int NPW = DQK == 96 ? 5 : (DQK == 64 ? 4 : 3);
    static_assert(3 * STG <= LDS_BYTES, "three stages must fit");
    const int tid = otid(), lane = tid & 63, wid = tid >> 6, h = lane >> 5, lr = lane & 31;
    const int pr = (lr & ~12) | ((lr & 4) << 1) | ((lr & 8) >> 1);
    bf16x8 qf[DQK / 16];
#pragma unroll
    for (int ks = 0; ks < DQK / 16; ++ks) qf[ks] = *(const bf16x8*)(Qw + (size_t)lr * DQK + ks * 16 + 8 * h);
#pragma unroll
    for (int r = 0; r < 16; ++r) { O[0][r] = 0.f; O[1][r] = 0.f; }
    float m = 0.f, lsum = 0.f; bool has_ref = false;
    const int n = kt1 - kt0;
    unsigned soff[NPW], doff[NPW];
    {
        const int r8 = lane >> 3, p8 = lane & 7, r4 = lane >> 2, p4 = lane & 3;
        if (DQK >= 64) {
#pragma unroll
            for (int i = 0; i < 2; ++i) { const int g = wid + 4 * i, row = 8 * g + r8; soff[i] = (unsigned)(row * DQK + (p8 ^ ((row >> 1) & 7)) * 8); doff[i] = (unsigned)(g * 1024); }
            if (DQK == 96) { const int row = 16 * wid + r4; soff[2] = (unsigned)(row * DQK + 64 + (p4 ^ ((row >> 2) & 3)) * 8); doff[2] = (unsigned)(KMAIN + wid * 1024); }
        } else { const int row = 16 * wid + r4; soff[0] = (unsigned)(row * DQK + (p4 ^ ((row >> 2) & 3)) * 8); doff[0] = (unsigned)(wid * 1024); }
#pragma unroll
        for (int i = 0; i < 2; ++i) { const int g = wid + 4 * i, row = 8 * g + r8; soff[NPW - 2 + i] = (unsigned)(row * NKEY + (p8 ^ ((row >> 1) & 7)) * 8); doff[NPW - 2 + i] = (unsigned)(VOFF + g * 1024); }
    }
    const unsigned lbase = (unsigned)(size_t)lds;
#define AP_DMA(kt_, off_) do { \
        _Pragma("unroll") for (int i = 0; i < NPW - 2; ++i) __builtin_amdgcn_global_load_lds((const unsigned*)(Kh + (size_t)(kt_) * 64 * DQK + soff[i]), (LASP unsigned*)(lbase + (unsigned)(off_) + doff[i]), 16, 0, 0); \
        _Pragma("unroll") for (int i = NPW - 2; i < NPW; ++i) __builtin_amdgcn_global_load_lds((const unsigned*)(VTh + (size_t)(kt_) * 64 + soff[i]), (LASP unsigned*)(lbase + (unsigned)(off_) + doff[i]), 16, 0, 0); } while (0)
    const int swk = (pr >> 1) & 7, swr = (pr >> 2) & 3, swv = (lr >> 1) & 7;
#define AP_KADDR(ks_) (DQK >= 64 ? ((ks_) < 4 ? pr * 128 + (((ks_) * 2 + h) ^ swk) * 16 : KMAIN + pr * 64 + ((((ks_) - 4) * 2 + h) ^ swr) * 16) : pr * 64 + (((ks_) * 2 + h) ^ swr) * 16)
#define AP_KROW32(ks_) ((DQK >= 64 && (ks_) < 4) ? 32 * 128 : 32 * 64)
#define AP_QKCHAIN(Sx0, Sx1, kb_) do { _Pragma("unroll") for (int ks = 0; ks < DQK / 16; ++ks) { \
            const bf16x8 k0_ = *(const bf16x8*)((kb_) + AP_KADDR(ks)), k1_ = *(const bf16x8*)((kb_) + AP_KADDR(ks) + AP_KROW32(ks)); \
            Sx0 = __builtin_amdgcn_mfma_f32_32x32x16_bf16(k0_, qf[ks], Sx0, 0, 0, 0); Sx1 = __builtin_amdgcn_mfma_f32_32x32x16_bf16(k1_, qf[ks], Sx1, 0, 0, 0); } } while (0)
#define AP_QK(Sx0, Sx1, off_) do { const unsigned char* kbq_ = lds + (off_); \
        if (has_ref) { const float ni_ = -m; _Pragma("unroll") for (int r = 0; r < 16; ++r) { Sx0[r] = ni_; Sx1[r] = ni_; } AP_QKCHAIN(Sx0, Sx1, kbq_); } \
        else { _Pragma("unroll") for (int r = 0; r < 16; ++r) { Sx0[r] = 0.f; Sx1[r] = 0.f; } AP_QKCHAIN(Sx0, Sx1, kbq_); } } while (0)
#define AP_BODY(t_, Sc0, Sc1, Sn0, Sn1, DMA_, NXT_) do { \
        constexpr bool nxt_ = NXT_; \
        if (DMA_) AP_DMA(kt0 + (t_) + 2, ow); \
        if (nxt_) AP_QK(Sn0, Sn1, ok); \
        if (((t_) & 3) == 0) {   \
        const float seed_ = fmaxf(Sc0[15], Sc1[15]); \
        float mxa_ = max3f(seed_, Sc0[0], Sc0[1]), mxb_ = max3f(seed_, Sc1[0], Sc1[1]); \
        _Pragma("unroll") for (int r = 2; r < 14; r += 2) { mxa_ = max3f(mxa_, Sc0[r], Sc0[r + 1]); mxb_ = max3f(mxb_, Sc1[r], Sc1[r + 1]); } \
        float mx_ = max3f(mxa_, mxb_, Sc0[14]); mx_ = max3f(mx_, Sc1[14], mx_); mx_ = xhalf_max(mx_); \
        const bool first_ = (t_) == 0; \
        if (__any(mx_ > 40.f || (first_ && mx_ < -40.f))) { \
            const float dm_ = (mx_ > 40.f || (first_ && mx_ < -40.f)) ? mx_ : 0.f; \
            if (!first_) { const float al_ = fexp2(-dm_); lsum *= al_; _Pragma("unroll") for (int r = 0; r < 16; ++r) { O[0][r] *= al_; O[1][r] *= al_; } } \
            m += dm_; has_ref = true; \
            _Pragma("unroll") for (int r = 0; r < 16; ++r) { Sc0[r] -= dm_; Sc1[r] -= dm_; } \
            if (nxt_) { _Pragma("unroll") for (int r = 0; r < 16; ++r) { Sn0[r] -= dm_; Sn1[r] -= dm_; } } \
        } } \
        float ps_ = 0.f, pt_ = 0.f; \
        _Pragma("unroll") for (int r = 0; r < 16; ++r) { Sc0[r] = fexp2(Sc0[r]); Sc1[r] = fexp2(Sc1[r]); ps_ += Sc0[r]; pt_ += Sc1[r]; } \
        lsum += ps_ + pt_; \
        u32x4 pw_[4]; \
        _Pragma("unroll") for (int q = 0; q < 2; ++q) { const int o = q * 8; \
            pw_[q].x = pk_bf16(Sc0[o], Sc0[o + 1]); pw_[q].y = pk_bf16(Sc0[o + 2], Sc0[o + 3]); pw_[q].z = pk_bf16(Sc0[o + 4], Sc0[o + 5]); pw_[q].w = pk_bf16(Sc0[o + 6], Sc0[o + 7]); \
            pw_[2 + q].x = pk_bf16(Sc1[o], Sc1[o + 1]); pw_[2 + q].y = pk_bf16(Sc1[o + 2], Sc1[o + 3]); pw_[2 + q].z = pk_bf16(Sc1[o + 4], Sc1[o + 5]); pw_[2 + q].w = pk_bf16(Sc1[o + 6], Sc1[o + 7]); } \
        { const unsigned char* vb_ = lds + ov + VOFF + lr * 128; \
          _Pragma("unroll") for (int ksp = 0; ksp < 4; ++ksp) { const int vp_ = ((ksp * 2 + h) ^ swv) * 16; const bf16x8 v0_ = *(const bf16x8*)(vb_ + vp_), v1_ = *(const bf16x8*)(vb_ + 32 * 128 + vp_); const bf16x8 pc_ = __builtin_bit_cast(bf16x8, pw_[ksp]); \
              O[0] = __builtin_amdgcn_mfma_f32_32x32x16_bf16(v0_, pc_, O[0], 0, 0, 0); O[1] = __builtin_amdgcn_mfma_f32_32x32x16_bf16(v1_, pc_, O[1], 0, 0, 0); } } \
        asm volatile("s_waitcnt vmcnt(0)" ::: "memory");     \
        __syncthreads(); \
        { const int tmp_ = ov; ov = ok; ok = ow; ow = tmp_; } } while (0)
    int ov = 0, ok = STG, ow = 2 * STG;
    f32x16 Sa0, Sa1, Sb0, Sb1;
    AP_DMA(kt0, 0); AP_DMA(kt0 + 1, STG);
    asm volatile("s_waitcnt vmcnt(0)" ::: "memory");
    __syncthreads();
    AP_QK(Sa0, Sa1, 0);
    int t = 0;
    for (; t < n - 2; t += 2) {
        AP_BODY(t, Sa0, Sa1, Sb0, Sb1, true, true);
        AP_BODY(t + 1, Sb0, Sb1, Sa0, Sa1, true, true);
    }
    AP_BODY(t, Sa0, Sa1, Sb0, Sb1, false, true);
    AP_BODY(t + 1, Sb0, Sb1, Sa0, Sa1, false, false);
#undef AP_DMA
#undef AP_KADDR
#undef AP_KROW32
#undef AP_QKCHAIN
#undef AP_QK
#undef AP_BODY
    lfin = xhalf_sum(lsum);
}

__device__ __forceinline__ void attn_gqa2(unsigned char* lds, const bf16_t* __restrict__ Qw, const bf16_t* __restrict__ Kh, const bf16_t* __restrict__ VTh, int kt0, int kt1, f32x16 (&O)[2][2], float (&lfin)[2]) {
    constexpr int DQK = 64, VOFF = 8192, STG = 16384;
    const int tid = otid(), lane = tid & 63, wid = tid >> 6, h = lane >> 5, lr = lane & 31;
    const int pr = (lr & ~12) | ((lr & 4) << 1) | ((lr & 8) >> 1);
    bf16x8 qf[2][4];
#pragma unroll
    for (int c = 0; c < 2; ++c)
#pragma unroll
        for (int ks = 0; ks < 4; ++ks) qf[c][ks] = *(const bf16x8*)(Qw + (size_t)(c * 32 + lr) * DQK + ks * 16 + 8 * h);
#pragma unroll
    for (int c = 0; c < 2; ++c)
#pragma unroll
        for (int r = 0; r < 16; ++r) { O[c][0][r] = 0.f; O[c][1][r] = 0.f; }
    float m[2] = {0.f, 0.f}, lsum[2] = {0.f, 0.f}; bool has_ref = false;
    const int n = kt1 - kt0;
    unsigned soff[4], doff[4];
    { const int r8 = lane >> 3, p8 = lane & 7;
#pragma unroll
      for (int i = 0; i < 2; ++i) { const int g = wid + 4 * i, row = 8 * g + r8, c = p8 ^ ((row >> 1) & 7);
          soff[i] = (unsigned)(row * DQK + c * 8); doff[i] = (unsigned)(g * 1024); soff[2 + i] = (unsigned)(row * NKEY + c * 8); doff[2 + i] = (unsigned)(VOFF + g * 1024); } }
    const unsigned lbase = (unsigned)(size_t)lds;
#define G2_DMA(kt_, off_) do { \
        _Pragma("unroll") for (int i = 0; i < 2; ++i) __builtin_amdgcn_global_load_lds((const unsigned*)(Kh + (size_t)(kt_) * 64 * DQK + soff[i]), (LASP unsigned*)(lbase + (unsigned)(off_) + doff[i]), 16, 0, 0); \
        _Pragma("unroll") for (int i = 2; i < 4; ++i) __builtin_amdgcn_global_load_lds((const unsigned*)(VTh + (size_t)(kt_) * 64 + soff[i]), (LASP unsigned*)(lbase + (unsigned)(off_) + doff[i]), 16, 0, 0); } while (0)
    const int swk = (pr >> 1) & 7, swv = (lr >> 1) & 7;
    G2_DMA(kt0, 0);
    asm volatile("s_waitcnt vmcnt(0)" ::: "memory");
    __syncthreads();
    for (int t = 0; t < n; ++t) {
        const int so = (t & 1) * STG;
        if (t + 1 < n) G2_DMA(kt0 + t + 1, STG - so);
        const bool chk = (t & 3) == 0, first = t == 0;
        u32x4 pw[2][4];
        f32x16 S[2][2];
#define G2_QK2() do { const unsigned char* kb = lds + so + pr * 128; _Pragma("unroll") for (int ks = 0; ks < 4; ++ks) { const int kp = ((ks * 2 + h) ^ swk) * 16; \
            const bf16x8 k0 = *(const bf16x8*)(kb + kp), k1 = *(const bf16x8*)(kb + 32 * 128 + kp); \
            S[0][0] = __builtin_amdgcn_mfma_f32_32x32x16_bf16(k0, qf[0][ks], S[0][0], 0, 0, 0); S[0][1] = __builtin_amdgcn_mfma_f32_32x32x16_bf16(k1, qf[0][ks], S[0][1], 0, 0, 0); \
            S[1][0] = __builtin_amdgcn_mfma_f32_32x32x16_bf16(k0, qf[1][ks], S[1][0], 0, 0, 0); S[1][1] = __builtin_amdgcn_mfma_f32_32x32x16_bf16(k1, qf[1][ks], S[1][1], 0, 0, 0); } } while (0)
        if (has_ref) {
#pragma unroll
            for (int c = 0; c < 2; ++c) { const float ni = -m[c];
#pragma unroll
                for (int r = 0; r < 16; ++r) { S[c][0][r] = ni; S[c][1][r] = ni; } }
            G2_QK2();
        } else {
#pragma unroll
            for (int c = 0; c < 2; ++c)
#pragma unroll
                for (int r = 0; r < 16; ++r) { S[c][0][r] = 0.f; S[c][1][r] = 0.f; }
            G2_QK2();
        }
#undef G2_QK2
        __builtin_amdgcn_sched_barrier(0);
        bf16x8 vf[8];
#pragma unroll
        for (int c = 0; c < 2; ++c) {
            if (chk) {
                const float seed = fmaxf(S[c][0][15], S[c][1][15]);
                float mxa = max3f(seed, S[c][0][0], S[c][0][1]), mxb = max3f(seed, S[c][1][0], S[c][1][1]);
#pragma unroll
                for (int r = 2; r < 14; r += 2) { mxa = max3f(mxa, S[c][0][r], S[c][0][r + 1]); mxb = max3f(mxb, S[c][1][r], S[c][1][r + 1]); }
                float mx = max3f(mxa, mxb, S[c][0][14]); mx = max3f(mx, S[c][1][14], mx);
                if (__any(first || mx > 40.f)) {
                    const float mq = xhalf_max(mx);
                    const float dm = (mq > 40.f || (first && mq < -40.f)) ? mq : 0.f;
                    if (!first) { const float al = fexp2(-dm); lsum[c] *= al;
#pragma unroll
                        for (int r = 0; r < 16; ++r) { O[c][0][r] *= al; O[c][1][r] *= al; } }
                    m[c] += dm; has_ref = true;
#pragma unroll
                    for (int r = 0; r < 16; ++r) { S[c][0][r] -= dm; S[c][1][r] -= dm; }
                }
            }
            float ps = 0.f, pt = 0.f;
#pragma unroll
            for (int r = 0; r < 16; ++r) { S[c][0][r] = fexp2(S[c][0][r]); S[c][1][r] = fexp2(S[c][1][r]); ps += S[c][0][r]; pt += S[c][1][r]; }
            lsum[c] += ps + pt;
#pragma unroll
            for (int q2 = 0; q2 < 2; ++q2) { const int o = q2 * 8;
                pw[c][q2].x = pk_bf16(S[c][0][o], S[c][0][o + 1]); pw[c][q2].y = pk_bf16(S[c][0][o + 2], S[c][0][o + 3]); pw[c][q2].z = pk_bf16(S[c][0][o + 4], S[c][0][o + 5]); pw[c][q2].w = pk_bf16(S[c][0][o + 6], S[c][0][o + 7]);
                pw[c][2 + q2].x = pk_bf16(S[c][1][o], S[c][1][o + 1]); pw[c][2 + q2].y = pk_bf16(S[c][1][o + 2], S[c][1][o + 3]); pw[c][2 + q2].z = pk_bf16(S[c][1][o + 4], S[c][1][o + 5]); pw[c][2 + q2].w = pk_bf16(S[c][1][o + 6], S[c][1][o + 7]); }
            __builtin_amdgcn_sched_barrier(0);
            if (c == 0) { const unsigned char* vb = lds + so + VOFF + lr * 128;
#pragma unroll
                for (int ksp = 0; ksp < 4; ++ksp) { const int vp = ((ksp * 2 + h) ^ swv) * 16; vf[2 * ksp] = *(const bf16x8*)(vb + vp); vf[2 * ksp + 1] = *(const bf16x8*)(vb + 32 * 128 + vp); }
                __builtin_amdgcn_sched_barrier(0); }
        }
        {
#pragma unroll
          for (int ksp = 0; ksp < 4; ++ksp) {
              const bf16x8 v0 = vf[2 * ksp], v1 = vf[2 * ksp + 1];
              const bf16x8 p0 = __builtin_bit_cast(bf16x8, pw[0][ksp]), p1 = __builtin_bit_cast(bf16x8, pw[1][ksp]);
              O[0][0] = __builtin_amdgcn_mfma_f32_32x32x16_bf16(v0, p0, O[0][0], 0, 0, 0); O[0][1] = __builtin_amdgcn_mfma_f32_32x32x16_bf16(v1, p0, O[0][1], 0, 0, 0);
              O[1][0] = __builtin_amdgcn_mfma_f32_32x32x16_bf16(v0, p1, O[1][0], 0, 0, 0); O[1][1] = __builtin_amdgcn_mfma_f32_32x32x16_bf16(v1, p1, O[1][1], 0, 0, 0); } }
        asm volatile("s_waitcnt vmcnt(0)" ::: "memory");
        __syncthreads();
    }
#undef G2_DMA
    lfin[0] = xhalf_sum(lsum[0]); lfin[1] = xhalf_sum(lsum[1]);
}

__device__ __forceinline__ void store_o(bf16_t* yrow  , const f32x16 (&O)[2], int h) {
#pragma unroll
    for (int mb = 0; mb < 2; ++mb)
#pragma unroll
        for (int q4 = 0; q4 < 4; ++q4) { u32x2 w; w.x = pk_bf16(O[mb][q4 * 4], O[mb][q4 * 4 + 1]); w.y = pk_bf16(O[mb][q4 * 4 + 2], O[mb][q4 * 4 + 3]); *(u32x2*)(yrow + mb * 32 + q4 * 8 + 4 * h) = w; }
}

__device__ __forceinline__ int tok_row(int b, int qrow) { return qrow < SEQ ? b * SEQ + qrow : NLAT + b * CTXL + (qrow - SEQ); }
__device__ __forceinline__ void attn_unit(unsigned char* lds, const Params& p, int l, int type, int b, int head, int qb) {
    const int tid = otid(), lane = tid & 63, wid = tid >> 6, h = lane >> 5, lr = lane & 31;
    const int kt0 = qb < 64 ? 0 : 128, kt1 = 132;
    const int qrow0 = qb * 128 + wid * 32;
    bf16_t* y = p.hbuf + (size_t)tok_row(b, qrow0 + lr) * DM;
    f32x16 O[2]; float lf;
    if (type == 0) {
        const size_t hb = (size_t)(b * 4 + head);
        attn_pipe<96>(lds, p.Qm + (hb * NKEY + qrow0) * 96, p.Km + hb * NKEY * 96, p.VmT + hb * 64 * NKEY, kt0, kt1, O, lf);
        const float inv = 1.f / lf;
#pragma unroll
        for (int r = 0; r < 16; ++r) { O[0][r] *= inv; O[1][r] *= inv; }
        store_o(y + head * 64, O, h);
    } else if (type == 2) {
        const int kt0g = qb < 32 ? 0 : 128, qrow0g = qb * 256 + wid * 64;
        const size_t hq = (size_t)(b * 8 + head), hk = (size_t)(b * 2 + (head >> 2));
        f32x16 O2[2][2]; float lf2[2];
        attn_gqa2(lds, p.Qg + (hq * NKEY + qrow0g) * 64, p.Kg + hk * NKEY * 64, p.VgT + hk * 64 * NKEY, kt0g, kt1, O2, lf2);
#pragma unroll
        for (int c = 0; c < 2; ++c) { const float inv = 1.f / lf2[c];
#pragma unroll
            for (int r = 0; r < 16; ++r) { O2[c][0][r] *= inv; O2[c][1][r] *= inv; }
            store_o(p.hbuf + (size_t)tok_row(b, qrow0g + c * 32 + lr) * DM + 512 + head * 64, O2[c], h); }
    } else {
        f32x16 O1[2];
        const size_t m0 = (size_t)(b * 8 + 2 * head) * NKEY, m1 = m0 + NKEY;
        attn_pipe<32>(lds, p.Qd + (m0 + qrow0) * 32, p.Kd + m0 * 32, p.VdT + (size_t)(b * 4 + head) * 64 * NKEY, kt0, kt1, O1, lf);
        const float inv1 = 1.f / lf;
#pragma unroll
        for (int r = 0; r < 16; ++r) { O1[0][r] *= inv1; O1[1][r] *= inv1; }
        attn_pipe<32>(lds, p.Qd + (m1 + qrow0) * 32, p.Kd + m1 * 32, p.VdT + (size_t)(b * 4 + head) * 64 * NKEY, kt0, kt1, O, lf);
        const float inv2 = p.lam[l] / lf;
        float ss = 0.f;
#pragma unroll
        for (int r = 0; r < 16; ++r) { O[0][r] = O1[0][r] - inv2 * O[0][r]; O[1][r] = O1[1][r] - inv2 * O[1][r]; ss += O[0][r] * O[0][r] + O[1][r] * O[1][r]; }
        ss = xhalf_sum(ss);
        const float lam_init = 0.8f - 0.6f * __expf(-0.3f * (float)l);
        const float rinv = frsq(ss * (1.f / 64.f) + EPS) * (1.f - lam_init);
        const float* g = p.g_diff_sub + l * 64;
#pragma unroll
        for (int mb = 0; mb < 2; ++mb)
#pragma unroll
            for (int q4 = 0; q4 < 4; ++q4) { const f32x4 gv = *(const f32x4*)(g + mb * 32 + q4 * 8 + 4 * h);
#pragma unroll
                for (int e = 0; e < 4; ++e) O[mb][q4 * 4 + e] *= rinv * gv[e]; }
        store_o(y + 256 + head * 64, O, h);
    }
}

__device__ __forceinline__ void attn_phase(unsigned char* lds, const Params& p, int l) {
    __shared__ int s_unit;
    const int qlen = 192 + (l == 0 ? 6 : 0);
    const int xcc = (int)(__builtin_amdgcn_s_getreg((3 << 11) | 20) & 7u);
    for (int xo = 0; xo < 8; ++xo) {
        const int q = (xcc + xo) & 7;
        unsigned* ctr = p.counters + l * 8 + q;
        for (;;) {
            if (otid() == 0) s_unit = (int)atomicAdd(ctr, 1u);
            __syncthreads();
            const int i = s_unit;
            __syncthreads();
            if (i >= qlen) break;
            int type, b, head, qb;
            if (i < 64) { type = 2; b = q >> 2; head = ((q >> 1) & 1) * 4 + (q & 1) * 2 + (i >> 5); qb = i & 31; }
            else if (i < 128) { type = 1; b = q >> 2; head = q & 3; qb = i - 64; }
            else if (i < 192) { type = 0; b = q >> 2; head = q & 3; qb = i - 128; }
            else { const int j = q * 6 + (i - 192);
                if (j < 16) { type = 2; b = j >> 3; head = j & 7; qb = 32; } else if (j < 32) { const int w = j - 16; type = 1; b = w >> 3; head = (w >> 1) & 3; qb = 64 + (w & 1); }
                else { const int w = j - 32; type = 0; b = w >> 3; head = (w >> 1) & 3; qb = 64 + (w & 1); } }
            attn_unit(lds, p, l, type, b, head, qb);
        }
    }
}

__device__ __forceinline__ void norm_store(const f32x4 (&v)[4], float ss, const float* g, const float* sc, const float* sh, bf16_t* hrow, int lane) {
    const float r = frsq(ss * (1.f / 1024.f) + EPS);
#pragma unroll
    for (int i = 0; i < 4; ++i) { const int c = i * 256 + lane * 4; const f32x4 gg = *(const f32x4*)(g + c), s1 = *(const f32x4*)(sc + c), s0 = *(const f32x4*)(sh + c);
        float o[4];
#pragma unroll
        for (int e = 0; e < 4; ++e) o[e] = v[i][e] * r * gg[e] * (1.f + s1[e]) + s0[e];
        u32x2 w; w.x = pk_bf16(o[0], o[1]); w.y = pk_bf16(o[2], o[3]); *(u32x2*)(hrow + c) = w; }
}
__device__ __forceinline__ void phase_prenorm0(const Params& p) {
    const int tid = otid(), lane = tid & 63, gw = blockIdx.x * 4 + (tid >> 6), nw = gridDim.x * 4;
    for (int row = gw; row < NT; row += nw) {
        const float* xr = xin_row(p, 0, row); f32x4 v[4]; float ss = 0.f;
#pragma unroll
        for (int i = 0; i < 4; ++i) { v[i] = *(const f32x4*)(xr + i * 256 + lane * 4); ss += v[i][0] * v[i][0] + v[i][1] * v[i][1] + v[i][2] * v[i][2] + v[i][3] * v[i][3]; }
        ss = wave_sum(ss);
        const float* m = p.mod + (size_t)mod_vec(row) * 6144;
        norm_store(v, ss, p.g_attn_pre, m + 1024, m, p.hbuf + (size_t)row * DM, lane);
    }
}
__device__ __forceinline__ void phase_rowupdate(const Params& p, int l, int which) {
    const int tid = otid(), lane = tid & 63, gw = blockIdx.x * 4 + (tid >> 6), nw = gridDim.x * 4;
    const bool last = l == DEPTH - 1; const int nrows = last ? NLAT : NT;
    for (int row = gw; row < nrows; row += nw) {
        const bf16_t* yr = (const bf16_t*)p.Yf + (size_t)row * DM; const float* xo = which == 0 ? xin_row(p, l, row) : xw_row(p, row); float* xn = xw_row(p, row);
        const float* m = p.mod + (size_t)(l * 3 + mod_vec(row)) * 6144;
        const float* gate = m + (which == 0 ? 2048 : 5120); const float* gp = (which == 0 ? p.g_attn_post : p.g_ffn_post) + l * DM;
        f32x4 y[4], x[4]; float ss = 0.f;
#pragma unroll
        for (int i = 0; i < 4; ++i) { const u32x2 yb = *(const u32x2*)(yr + i * 256 + lane * 4); y[i] = (f32x4){__uint_as_float(yb.x << 16), __uint_as_float(yb.x & 0xffff0000u), __uint_as_float(yb.y << 16), __uint_as_float(yb.y & 0xffff0000u)}; x[i] = *(const f32x4*)(xo + i * 256 + lane * 4); ss += y[i][0] * y[i][0] + y[i][1] * y[i][1] + y[i][2] * y[i][2] + y[i][3] * y[i][3]; }
        ss = wave_sum(ss);
        const float r = frsq(ss * (1.f / 1024.f) + EPS); float s2 = 0.f;
#pragma unroll
        for (int i = 0; i < 4; ++i) { const int c = i * 256 + lane * 4; const f32x4 gt = *(const f32x4*)(gate + c), gg = *(const f32x4*)(gp + c);
#pragma unroll
            for (int e = 0; e < 4; ++e) { x[i][e] += gt[e] * (y[i][e] * r * gg[e]); s2 += x[i][e] * x[i][e]; }
            *(f32x4*)(xn + c) = x[i]; }
        if (which == 0) { s2 = wave_sum(s2); norm_store(x, s2, p.g_ffn_pre + l * DM, m + 4096, m + 3072, p.hbuf + (size_t)row * DM, lane); }
        else if (!last) { s2 = wave_sum(s2); const float* m2 = p.mod + (size_t)((l + 1) * 3 + mod_vec(row)) * 6144; norm_store(x, s2, p.g_attn_pre + (l + 1) * DM, m2 + 1024, m2, p.hbuf + (size_t)row * DM, lane); }
    }
}

__device__ __forceinline__ void conv_tile(unsigned char* lds, const float* __restrict__ src, int K, int N, int kt, int nt, bf16_t* dst, int mode, const float* kscale) {
    float* tile = (float*)lds;
    const int tid = otid(), k0 = kt * 64, n0 = nt * 64;
#pragma unroll 4
    for (int i = 0; i < 16; ++i) { const int k = i * 4 + (tid >> 6), n = tid & 63; float v = 0.f; if (n0 + n < N) { v = src[(size_t)(k0 + k) * N + n0 + n]; if (kscale) v *= kscale[k0 + k]; } tile[k * 65 + n] = v; }
    __syncthreads();
#pragma unroll
    for (int jj = 0; jj < 2; ++jj) { const int c = tid + 256 * jj, n = c >> 3, kc = c & 7, ng = n0 + n;
        if (ng < N) { int row;
            if (mode == 1) row = ng < 384 ? ng : (ng < 416 ? ng + 1536 : ng - 32);
            else if (mode == 2) row = 32 * (ng >> 4) + (ng & 15);
            else if (mode == 3) row = 32 * (ng >> 4) + 16 + (ng & 15);
            else row = ng;
            float e[8];
#pragma unroll
            for (int q = 0; q < 8; ++q) e[q] = tile[(kc * 8 + q) * 65 + n];
            u32x4 w; w.x = pk_bf16(e[0], e[1]); w.y = pk_bf16(e[2], e[3]); w.z = pk_bf16(e[4], e[5]); w.w = pk_bf16(e[6], e[7]);
            *(u32x4*)(dst + (size_t)row * K + k0 + kc * 8) = w; } }
    __syncthreads();
}
__device__ __forceinline__ void sincos_d(double x, float& s, float& c) {
    const double n = rint(x * 0.63661977236758134308);
    double r = x - n * 1.57079632679489655800; r -= n * 6.12323399573676603587e-17;
    const double r2 = r * r;
    double sp = r * (1.0 + r2 * (-1.0 / 6 + r2 * (1.0 / 120 + r2 * (-1.0 / 5040 + r2 * (1.0 / 362880 + r2 * (-1.0 / 39916800 + r2 * (1.0 / 6227020800.0)))))));
    double cp = 1.0 + r2 * (-0.5 + r2 * (1.0 / 24 + r2 * (-1.0 / 720 + r2 * (1.0 / 40320 + r2 * (-1.0 / 3628800 + r2 * (1.0 / 479001600.0))))));
    const int q = ((int)n) & 3;
    const double ss = (q == 0) ? sp : (q == 1) ? cp : (q == 2) ? -sp : -cp;
    const double cc = (q == 0) ? cp : (q == 1) ? -sp : (q == 2) ? -cp : sp;
    s = (float)ss; c = (float)cc;
}
constexpr int CONV_PER_LAYER = 2904, N_CONV = 2 * CONV_PER_LAYER, N_ADA = 192, N_ROPE = 1536, N_PAD = 2;
__device__ __forceinline__ void phase_prologue(unsigned char* lds, const Params& p) {
    const int tid = otid();
    const int total = N_CONV + N_ADA + N_ROPE + N_PAD;
    for (int u = blockIdx.x; u < total; u += gridDim.x) {
        if (u < N_ADA) {
            const int wu = u * 4 + (tid >> 6), lane = tid & 63, l = wu / 384, rem = wu - l * 384, cc = rem >> 4, kc = rem & 15;
            const int col = cc * 256 + lane * 4; f32x4 a0 = {0, 0, 0, 0}, a1 = a0, a2 = a0;
            const float* wbase = p.w_ada + ((size_t)l * 1024 + kc * 64) * 6144 + col;
#pragma unroll 8
            for (int k = 0; k < 64; ++k) { const int kk = kc * 64 + k; const f32x4 w = *(const f32x4*)(wbase + (size_t)k * 6144);
                const float c0 = p.c[kk], c1 = p.c[1024 + kk], c2 = p.c_ctx[kk];
                const float s0 = c0 / (1.f + __expf(-c0)), s1 = c1 / (1.f + __expf(-c1)), s2 = c2 / (1.f + __expf(-c2));
                a0 += w * s0; a1 += w * s1; a2 += w * s2; }
            float* o = p.adapart + ((size_t)(l * 16 + kc) * 3) * 6144 + col;
            *(f32x4*)o = a0; *(f32x4*)(o + 6144) = a1; *(f32x4*)(o + 2 * 6144) = a2;
        } else if (u < N_ADA + N_CONV) {
            const int v = u - N_ADA, l = v / CONV_PER_LAYER, ti = v - l * CONV_PER_LAYER;
            if (ti < 496) conv_tile(lds, p.w_in + (size_t)l * 1024 * 1952, 1024, 1952, ti / 31, ti % 31, p.wt_in + (size_t)l * INW * 1024, 1, nullptr);
            else if (ti < 520) { const int q = ti - 496; conv_tile(lds, p.w_mla_qb + (size_t)l * 256 * 384, 256, 384, q / 6, q % 6, p.wt_qb + (size_t)l * 384 * 256, 0, p.g_mla_q + l * 256); }
            else if (ti < 536) { const int q = ti - 520; conv_tile(lds, p.w_mla_kvb + (size_t)l * 128 * 512, 128, 512, q / 8, q % 8, p.wt_kvb + (size_t)l * 512 * 128, 0, p.g_mla_kv + l * 128); }
            else if (ti < 792) { const int q = ti - 536; conv_tile(lds, p.w_out + (size_t)l * 1024 * 1024, 1024, 1024, q / 16, q % 16, p.wt_out + (size_t)l * 1024 * 1024, 0, nullptr); }
            else if (ti < 1496) { const int q = ti - 792; conv_tile(lds, p.w_gate + (size_t)l * 1024 * FFN, 1024, FFN, q / 44, q % 44, p.wt_gu + (size_t)l * 2 * FFN * 1024, 2, nullptr); }
            else if (ti < 2200) { const int q = ti - 1496; conv_tile(lds, p.w_up + (size_t)l * 1024 * FFN, 1024, FFN, q / 44, q % 44, p.wt_gu + (size_t)l * 2 * FFN * 1024, 3, nullptr); }
            else { const int q = ti - 2200; conv_tile(lds, p.w_down + (size_t)l * FFN * 1024, FFN, 1024, q / 16, q % 16, p.wt_down + (size_t)l * 1024 * FFN, 0, nullptr); }
        } else if (u < N_ADA + N_CONV + N_ROPE) {
            const int e = (u - N_ADA - N_CONV) * 256 + tid, pos = e / 48, a = e - pos * 48;
            const int row = pos >> 6, col = pos & 63;
            if (a < 16) { const float inv = exp2f(-(float)(a & 7) * (13.287712379549449f / 8.f)); const float ang = (float)(a < 8 ? row : col) * inv; float s, c; sincos_d((double)ang, s, c); p.cs16[((size_t)pos * 16 + a) * 2] = c; p.cs16[((size_t)pos * 16 + a) * 2 + 1] = s; }
            else { const int a2 = a - 16; const float inv = exp2f(-(float)(a2 & 15) * (13.287712379549449f / 16.f)); const float ang = (float)(a2 < 16 ? row : col) * inv; float s, c; sincos_d((double)ang, s, c); p.cs32[((size_t)pos * 32 + a2) * 2] = c; p.cs32[((size_t)pos * 32 + a2) * 2 + 1] = s; }
        } else {
            const int l = u - (N_ADA + N_CONV + N_ROPE); u32x4 z = {0, 0, 0, 0}; u32x4* d = (u32x4*)(p.wt_in + ((size_t)l * INW + 1952) * 1024);
            for (int i = tid; i < 96 * 1024 / 8; i += NTHREADS) d[i] = z;
        }
    }
}
__device__ __forceinline__ void phase_adareduce(const Params& p) {
    const int gt = blockIdx.x * NTHREADS + otid(), ntot = gridDim.x * NTHREADS;
    for (int i = gt; i < DEPTH * 3 * 6144; i += ntot) { const int l = i / (3 * 6144), r = i - l * 3 * 6144, v = r / 6144, col = r - v * 6144;
        float s = p.b_ada[l * 6144 + col];
#pragma unroll
        for (int kc = 0; kc < 16; ++kc) s += p.adapart[((size_t)(l * 16 + kc) * 3 + v) * 6144 + col];
        p.mod[i] = s; }
    if (gt < DEPTH) { const int l = gt; float a = 0.f, b = 0.f;
        for (int i = 0; i < 32; ++i) { a += p.lq1[l * 32 + i] * p.lk1[l * 32 + i]; b += p.lq2[l * 32 + i] * p.lk2[l * 32 + i]; }
        p.lam[l] = expf(a) - expf(b) + (0.8f - 0.6f * expf(-0.3f * (float)l)); }
}

#define XB_TMO      128
#define XB_XCNT(j)  (256  + 64 * (j))
#define XB_XSUB(j)  (1280 + 64 * (j))
#define XB_XGEN(j)  (2304 + 64 * (j))
#define XB_TOP      3328
#define XB_TOPGEN   3392
#define XCD_BAR_WORDS 3456
#define XB_SPIN_CAP (1u << 22)
#define LAS __attribute__((address_space(3)))
__device__ __forceinline__ unsigned xb_ld(unsigned* p)              { return __hip_atomic_load(p, __ATOMIC_RELAXED, __HIP_MEMORY_SCOPE_AGENT); }
__device__ __forceinline__ unsigned xb_add(unsigned* p, unsigned v) { return __hip_atomic_fetch_add(p, v, __ATOMIC_RELAXED, __HIP_MEMORY_SCOPE_AGENT); }
__device__ __forceinline__ unsigned xb_xcc_id() { return (unsigned)__builtin_amdgcn_s_getreg((3 << 11) | 20) & 0xFu; }
#define XB_SPIN(cond, bar) do { unsigned _sp = 0; while (cond) { __builtin_amdgcn_s_sleep(1); \
    if ((++_sp & 255u) == 0u) { if (xb_ld(&(bar)[XB_TMO])) break; if (_sp > XB_SPIN_CAP) { atomicAdd(&(bar)[XB_TMO], 1u); break; } } } } while (0)
struct XcdBarrier { unsigned* bar; unsigned x; volatile LAS unsigned* st; };
__device__ __forceinline__ XcdBarrier xcd_barrier_post(unsigned* bar, volatile LAS unsigned* st) {
    XcdBarrier b; b.bar = bar; b.x = xb_xcc_id(); b.st = st;
    if (threadIdx.x == 0) (void)xb_add(&bar[XB_XCNT(b.x)], 1u);
    return b;
}
__device__ __forceinline__ void xcd_barrier_complete(unsigned* bar, unsigned x, unsigned& nloc, unsigned& nx) {
    const unsigned G = gridDim.x * gridDim.y * gridDim.z;
    unsigned sum, cnt, mine, sp = 0u;
    for (;;) {
        sum = 0u; cnt = 0u; mine = 0u;
#pragma unroll
        for (unsigned j = 0; j < 16; ++j) { const unsigned c = xb_ld(&bar[XB_XCNT(j)]); sum += c; cnt += (c > 0u) ? 1u : 0u; mine = (j == x) ? c : mine; }
        if (sum == G) break;
        __builtin_amdgcn_s_sleep(1);
        if ((++sp & 255u) == 0u) { if (xb_ld(&bar[XB_TMO])) break; if (sp > XB_SPIN_CAP) { atomicAdd(&bar[XB_TMO], 1u); break; } }
    }
    nloc = mine > 0u ? mine : 1u; nx = cnt > 0u ? cnt : 1u;
}
__device__ __forceinline__ void xcd_barrier(const XcdBarrier& b) {
    asm volatile("s_waitcnt vmcnt(0)" ::: "memory");
    __syncthreads();
    if (threadIdx.x == 0) {
        unsigned* bar = b.bar;
        __builtin_amdgcn_s_waitcnt(0);
        unsigned nloc = b.st[0], nx = b.st[1];
        if (nloc == 0u) { xcd_barrier_complete(bar, b.x, nloc, nx); b.st[0] = nloc; b.st[1] = nx; }
        const unsigned old = xb_add(&bar[XB_XSUB(b.x)], 1u);
        const unsigned gen = old / nloc;
        if (old + 1u == (gen + 1u) * nloc) {
            __builtin_amdgcn_fence(__ATOMIC_RELEASE, "agent");
            asm volatile("s_waitcnt vmcnt(0)" ::: "memory");
            const unsigned og = xb_add(&bar[XB_TOP], 1u);
            const unsigned tg = og / nx;
            if (og + 1u == (tg + 1u) * nx) xb_add(&bar[XB_TOPGEN], 1u);
            else XB_SPIN(xb_ld(&bar[XB_TOPGEN]) == tg, bar);
            __builtin_amdgcn_fence(__ATOMIC_ACQUIRE, "agent");
            xb_add(&bar[XB_XGEN(b.x)], 1u);
            asm volatile("s_waitcnt vmcnt(0)" ::: "memory");
        } else {
            XB_SPIN(xb_ld(&bar[XB_XGEN(b.x)]) == gen, bar);
            __builtin_amdgcn_fence(__ATOMIC_ACQUIRE, "agent");
            asm volatile("s_waitcnt vmcnt(0)" ::: "memory");
        }
    }
    __syncthreads();
}

__device__ __forceinline__ void simple_barrier(unsigned* cnt, unsigned target) {
    asm volatile("s_waitcnt vmcnt(0)" ::: "memory");
    __syncthreads();
    if (threadIdx.x == 0) {
        __builtin_amdgcn_fence(__ATOMIC_RELEASE, "agent");
        asm volatile("s_waitcnt vmcnt(0)" ::: "memory");
        (void)__hip_atomic_fetch_add(cnt, 1u, __ATOMIC_RELAXED, __HIP_MEMORY_SCOPE_AGENT);
        unsigned sp = 0;
        while (__hip_atomic_load(cnt, __ATOMIC_RELAXED, __HIP_MEMORY_SCOPE_AGENT) < target) { __builtin_amdgcn_s_sleep(2); if (++sp > (1u << 24)) break; }
        __builtin_amdgcn_fence(__ATOMIC_ACQUIRE, "agent");
        asm volatile("s_waitcnt vmcnt(0)" ::: "memory");
    }
    __syncthreads();
}

constexpr int N_PHASES = 3 + 8 * DEPTH;
__global__ void __launch_bounds__(NTHREADS, 2) fwd_kernel(Params p) {
    extern __shared__ __attribute__((aligned(16))) unsigned char lds[];
    __shared__ uint4 xb_words;
    if (threadIdx.x == 0) xb_words = make_uint4(0u, 0u, 0u, 0u);
    __syncthreads();
    XcdBarrier xb = xcd_barrier_post(p.counters + 64, (volatile LAS unsigned*)&xb_words);
    for (int ph = p.phase_begin; ph < p.phase_end; ++ph) {
        if (ph == 0) phase_prologue(lds, p);
        else if (ph == 1) phase_adareduce(p);
        else if (ph == 2) phase_prenorm0(p);
        else {
            const int l = (ph - 3) >> 3, s = (ph - 3) & 7; const bool last = l == DEPTH - 1;
            if (s == 0) { EpiInProj e{&p, l}; gemm_phase(lds, p.wt_in + (size_t)l * INW * 1024, 1024, p.hbuf, DM, 1024, NT / 128, INW / 128, e); }
            else if (s == 1) {
                EpiMlaQ eq{&p}; EpiMlaKV ek{&p};
                const int nq = 136 * 3, nkv = 136 * 4;
                for (int u = blockIdx.x; u < nq + nkv; u += gridDim.x) { int tt, nt;
                    if (u < nq) { if (gemm_unit(u, NT / 128, 3, tt, nt)) gemm_tile(lds, p.wt_qb + (size_t)l * 384 * 256, 256, p.qkva, 384, 256, nt * 128, tt * 128, eq); }
                    else { if (gemm_unit(u - nq, NT / 128, 4, tt, nt)) gemm_tile(lds, p.wt_kvb + (size_t)l * 512 * 128, 128, p.qkva + 256, 384, 128, nt * 128, tt * 128, ek); } }
            }
            else if (s == 2) attn_phase(lds, p, l);
            else if (s == 3) gemm_phase_n1024(lds, p.wt_out + (size_t)l * 1024 * 1024, 1024, p.hbuf, DM, 1024, !last, (bf16_t*)p.Yf);
            else if (s == 4) phase_rowupdate(p, l, 0);
            else if (s == 5) { EpiSwiglu e{p.Gact}; gemm_phase(lds, p.wt_gu + (size_t)l * 2 * FFN * 1024, 1024, p.hbuf, DM, 1024, (last ? NLAT : NT) / 128, 44, e); }
            else if (s == 6) gemm_phase_n1024(lds, p.wt_down + (size_t)l * 1024 * FFN, FFN, p.Gact, FFN, FFN, !last, (bf16_t*)p.Yf);
            else phase_rowupdate(p, l, 1);
        }
        if (ph + 1 < p.phase_end) { if (p.coop == 1) xcd_barrier(xb); else if (p.coop == 3) simple_barrier(p.counters + 32, (unsigned)(ph - p.phase_begin + 1) * gridDim.x); else if (p.coop == 2) cg::this_grid().sync(); }
    }
}

extern "C" void kernel_launch(void* const* d_in, const int* in_sizes, int n_in, void* d_out, int out_size, void* d_ws, size_t ws_size, hipStream_t stream) {
    static int grid = 0;
    if (grid == 0) {
        int dev = 0, cus = 0, per_cu = 0;
        hipGetDevice(&dev); hipDeviceGetAttribute(&cus, hipDeviceAttributeMultiprocessorCount, dev);
        hipFuncSetAttribute((const void*)fwd_kernel, hipFuncAttributeMaxDynamicSharedMemorySize, LDS_BYTES);
        hipOccupancyMaxActiveBlocksPerMultiprocessor(&per_cu, (const void*)fwd_kernel, NTHREADS, LDS_BYTES);
        per_cu = 2;
        grid = cus * per_cu;
        fprintf(stderr, "kernel_launch: cus %d per_cu %d grid %d ws %zu\n", cus, per_cu, grid, ws_size);
    }
    Params p{};
    { const float* inp[26]; for (int i = 0; i < 26; ++i) inp[i] = (const float*)d_in[i]; memcpy((void*)&p, inp, sizeof(inp)); }
    p.out = (float*)d_out;
    unsigned char* w = (unsigned char*)d_ws; size_t off = 0;
    auto take = [&](size_t bytes) { unsigned char* r = w + off; off += (bytes + 255) & ~(size_t)255; return r; };
    p.counters = (unsigned*)take(256 + XCD_BAR_WORDS * 4);
    p.wt_in = (bf16_t*)take((size_t)2 * INW * 1024 * 2);
    p.wt_qb = (bf16_t*)take((size_t)2 * 384 * 256 * 2);
    p.wt_kvb = (bf16_t*)take((size_t)2 * 512 * 128 * 2);
    p.wt_out = (bf16_t*)take((size_t)2 * 1024 * 1024 * 2);
    p.wt_gu = (bf16_t*)take((size_t)2 * 2 * FFN * 1024 * 2);
    p.wt_down = (bf16_t*)take((size_t)2 * 1024 * FFN * 2);
    p.adapart = (float*)take((size_t)2 * 16 * 3 * 6144 * 4);
    p.mod = (float*)take((size_t)2 * 3 * 6144 * 4);
    p.lam = (float*)take(256);
    p.cs16 = (float*)take((size_t)SEQ * 16 * 2 * 4);
    p.cs32 = (float*)take((size_t)SEQ * 32 * 2 * 4);
    p.xc = (float*)take((size_t)NB * CTXL * DM * 4);
    p.ssq = (float*)take((size_t)NT * 8 * 4);
    p.hbuf = (bf16_t*)take((size_t)NT * DM * 2);
    p.Yf = (float*)take((size_t)NT * DM * 4); p.qkva = (bf16_t*)p.Yf;
    unsigned char* ra = take((size_t)NT * FFN * 2); p.Gact = (bf16_t*)ra;
    { size_t o2 = 0; auto tk = [&](size_t bytes) { unsigned char* r = ra + o2; o2 += (bytes + 255) & ~(size_t)255; return (bf16_t*)r; };
      p.Qm = tk((size_t)NB * 4 * NKEY * 96 * 2); p.Km = tk((size_t)NB * 4 * NKEY * 96 * 2); p.VmT = tk((size_t)NB * 4 * 64 * NKEY * 2);
      p.Qd = tk((size_t)NB * 8 * NKEY * 32 * 2); p.Kd = tk((size_t)NB * 8 * NKEY * 32 * 2); p.VdT = tk((size_t)NB * 4 * 64 * NKEY * 2);
      p.Qg = tk((size_t)NB * 8 * NKEY * 64 * 2); p.Kg = tk((size_t)NB * 2 * NKEY * 64 * 2); p.VgT = tk((size_t)NB * 2 * 64 * NKEY * 2);
      if (o2 > (size_t)NT * FFN * 2) { fprintf(stderr, "kernel_launch: region RA overflow\n"); return; } }
    if (off > ws_size) { fprintf(stderr, "kernel_launch: workspace too small: need %zu have %zu\n", off, ws_size); return; }
    (void)hipMemsetAsync(p.counters, 0, 256 + XCD_BAR_WORDS * 4, stream);
#if ONE_LAUNCH
    p.phase_begin = 0; p.phase_end = N_PHASES; p.coop = 1;
    void* args[] = {&p};
    hipError_t e = hipLaunchCooperativeKernel((const void*)fwd_kernel, dim3(grid), dim3(NTHREADS), args, LDS_BYTES, stream);
    if (e != hipSuccess) fprintf(stderr, "cooperative launch failed: %s (grid %d)\n", hipGetErrorString(e), grid);
#else
    for (int ph = 0; ph < N_PHASES; ++ph) { p.phase_begin = ph; p.phase_end = ph + 1; p.coop = 0; hipLaunchKernelGGL(fwd_kernel, dim3(grid), dim3(NTHREADS), LDS_BYTES, stream, p); }
#endif
}
```

```cpp
#include <hip/hip_runtime.h>
#include <hip/hip_cooperative_groups.h>
#include <stdint.h>
#include <stdio.h>
#include <string.h>
namespace cg = cooperative_groups;

#ifndef ONE_LAUNCH
#define ONE_LAUNCH 1
#endif

typedef unsigned short bf16_t;
typedef short bf16x8 __attribute__((ext_vector_type(8)));
typedef float f32x16 __attribute__((ext_vector_type(16)));
typedef float f32x4 __attribute__((ext_vector_type(4)));
typedef float f32x2 __attribute__((ext_vector_type(2)));
typedef unsigned u32x4 __attribute__((ext_vector_type(4)));
typedef unsigned u32x2 __attribute__((ext_vector_type(2)));

constexpr int DM = 1024, NB = 2, SEQ = 8192, CTXL = 256, NKEY = SEQ + CTXL, NLAT = NB * SEQ, NT = NLAT + NB * CTXL;
constexpr int FFN = 2816, INW = 2048, DEPTH = 2;
constexpr float EPS = 1e-6f, LOG2E = 1.4426950408889634f;
constexpr float MLA_SC = 0.10206207261596577f * LOG2E, DIFF_SC = 0.17677669529663687f * LOG2E, GQA_SC = 0.125f * LOG2E;
constexpr int LDS_BYTES = 73728;
constexpr int NTHREADS = 256;

struct Params {
    const float *x, *c, *ctx, *c_ctx, *w_ada, *b_ada, *g_attn_pre, *g_attn_post, *w_in, *g_mla_q, *w_mla_qb, *g_mla_kv, *w_mla_kvb,
        *lq1, *lk1, *lq2, *lk2, *g_diff_sub, *g_gqa_q, *g_gqa_k, *w_out, *g_ffn_pre, *g_ffn_post, *w_gate, *w_up, *w_down;
    float* out;
    bf16_t *wt_in, *wt_qb, *wt_kvb, *wt_out, *wt_gu, *wt_down;
    float *adapart, *mod, *lam, *cs16, *cs32, *xc, *ssq, *Yf;
    bf16_t *hbuf, *qkva, *Qm, *Km, *VmT, *Qd, *Kd, *VdT, *Qg, *Kg, *VgT, *Gact;
    unsigned* counters;
    int phase_begin, phase_end, coop, pad;
};

typedef __bf16 bf16x2_t __attribute__((ext_vector_type(2)));
__device__ __forceinline__ unsigned pk_bf16(float lo, float hi) { const f32x2 v = {lo, hi}; const bf16x2_t b = __builtin_convertvector(v, bf16x2_t); return __builtin_bit_cast(unsigned, b); }
__device__ __forceinline__ int otid() { int t = threadIdx.x; asm volatile("" : "+v"(t)); return t; }
__device__ __forceinline__ float fexp2(float x) { return __builtin_amdgcn_exp2f(x); }
__device__ __forceinline__ float max3f(float a, float b, float c) { float r; asm("v_max3_f32 %0, %1, %2, %3" : "=v"(r) : "v"(a), "v"(b), "v"(c)); return r; }
__device__ __forceinline__ float xhalf_max(float x) { return fmaxf(x, __shfl_xor(x, 32)); }
__device__ __forceinline__ float xhalf_sum(float x) { return x + __shfl_xor(x, 32); }
__device__ __forceinline__ float frsq(float x) { return __builtin_amdgcn_rsqf(x); }
__device__ __forceinline__ float wave_sum(float v) {
#pragma unroll
    for (int o = 32; o >= 1; o >>= 1) v += __shfl_xor(v, o);
    return v;
}
__device__ __forceinline__ void tok_decode(int t, int& b, int& j) { if (t < NLAT) { b = t >> 13; j = t & (SEQ - 1); } else { const int c = t - NLAT; b = c >> 8; j = SEQ + (c & (CTXL - 1)); } }
__device__ __forceinline__ const float* xin_row(const Params& p, int l, int t) {
    if (l == 0) return t < NLAT ? p.x + (size_t)t * DM : p.ctx + (size_t)(t - NLAT) * DM;
    return t < NLAT ? p.out + (size_t)t * DM : p.xc + (size_t)(t - NLAT) * DM;
}
__device__ __forceinline__ float* xw_row(const Params& p, int t) { return t < NLAT ? p.out + (size_t)t * DM : p.xc + (size_t)(t - NLAT) * DM; }
__device__ __forceinline__ int mod_vec(int t) { return t < NLAT ? (t >> 13) : 2; }

#define LASP __attribute__((address_space(3)))
typedef float f32x4acc __attribute__((ext_vector_type(4)));
template <class Epi>
__device__ __forceinline__ void gemm_tile(unsigned char* lds, const bf16_t* __restrict__ W, int ldw, const bf16_t* __restrict__ A, int lda, int K, int n0, int t0, const Epi& epi) {
    const int tid = otid(), lane = tid & 63, wid = tid >> 6, wn = wid >> 1, wt = wid & 1;
    const int dr = lane >> 3, dp = lane & 7;
    unsigned woff[4], aoff[4];
#pragma unroll
    for (int j = 0; j < 4; ++j) { const int row = (wid * 4 + j) * 8 + dr, c = dp ^ ((row >> 1) & 7);
        woff[j] = (unsigned)((n0 + row) * ldw + c * 8); aoff[j] = (unsigned)((t0 + row) * lda + c * 8); }
    const unsigned lbase = (unsigned)(size_t)lds + (unsigned)wid * 4096u;
    f32x4 acc[4][4];
#pragma unroll
    for (int a = 0; a < 4; ++a)
#pragma unroll
        for (int b = 0; b < 4; ++b) acc[a][b] = (f32x4){0.f, 0.f, 0.f, 0.f};
#define GT_DMA(kt_, st_) do { _Pragma("unroll") for (int j = 0; j < 4; ++j) { \
        __builtin_amdgcn_global_load_lds((const unsigned*)(W + woff[j] + (size_t)(kt_) * 64), (LASP unsigned*)(lbase + (unsigned)(st_) * 32768u + (unsigned)j * 1024u), 16, 0, 0); \
        __builtin_amdgcn_global_load_lds((const unsigned*)(A + aoff[j] + (size_t)(kt_) * 64), (LASP unsigned*)(lbase + (unsigned)(st_) * 32768u + 16384u + (unsigned)j * 1024u), 16, 0, 0); } } while (0)
    const int r16 = lane & 15, q = lane >> 4, sw = r16 >> 1;
    const int base_w = (wn * 64 + r16) * 128, base_a = 16384 + (wt * 64 + r16) * 128;
    const int nk = K >> 6;
    GT_DMA(0, 0);
    asm volatile("s_waitcnt vmcnt(0)" ::: "memory");
    __syncthreads();
    for (int kt = 0; kt < nk; ++kt) {
        const int st = kt & 1;
        if (kt + 1 < nk) GT_DMA(kt + 1, st ^ 1);
        const unsigned char* sb = lds + st * 32768;
#pragma unroll
        for (int ks = 0; ks < 2; ++ks) {
            const int pos = ((ks * 4 + q) ^ sw) * 16;
            bf16x8 fa[4], fb[4];
#pragma unroll
            for (int i = 0; i < 4; ++i) { fa[i] = *(const bf16x8*)(sb + base_w + i * 2048 + pos); fb[i] = *(const bf16x8*)(sb + base_a + i * 2048 + pos); }
#pragma unroll
            for (int ni = 0; ni < 4; ++ni)
#pragma unroll
                for (int ti = 0; ti < 4; ++ti) acc[ni][ti] = __builtin_amdgcn_mfma_f32_16x16x32_bf16(fa[ni], fb[ti], acc[ni][ti], 0, 0, 0);
            __builtin_amdgcn_sched_group_barrier(0x100, 8, 0);
            __builtin_amdgcn_sched_group_barrier(0x008, 16, 0);
        }
        asm volatile("s_waitcnt vmcnt(0)" ::: "memory");
        __syncthreads();
    }
#undef GT_DMA
    epi(acc, n0 + wn * 64, t0 + wt * 64, lane);
}

__device__ __forceinline__ bool gemm_unit(int u, int ntt, int nn, int& tt, int& nt) {
    const int xcd = u & 7, v = u >> 3; nt = v % nn; tt = (v / nn) * 8 + xcd; return tt < ntt;
}
__device__ __forceinline__ void store4(bf16_t* dst, const f32x4& v);
__device__ __forceinline__ void gemm_tile_small(unsigned char* lds, const bf16_t* __restrict__ W, int ldw, const bf16_t* __restrict__ A, int lda, int K, int n0, int t0, bf16_t* O, int ldo) {
    const int tid = otid(), lane = tid & 63, wid = tid >> 6;
    const int dr = lane >> 3, dp = lane & 7;
    unsigned woff[4], aoff;
#pragma unroll
    for (int j = 0; j < 4; ++j) { const int row = (wid * 4 + j) * 8 + dr, c = dp ^ ((row >> 1) & 7); woff[j] = (unsigned)((n0 + row) * ldw + c * 8); }
    { const int row = wid * 8 + dr, c = dp ^ ((row >> 1) & 7); aoff = (unsigned)((t0 + row) * lda + c * 8); }
    const unsigned lbase = (unsigned)(size_t)lds;
    f32x4 acc[2][2];
#pragma unroll
    for (int a = 0; a < 2; ++a) { acc[a][0] = (f32x4){0.f, 0.f, 0.f, 0.f}; acc[a][1] = (f32x4){0.f, 0.f, 0.f, 0.f}; }
#define GS_DMA(kt_, st_) do { _Pragma("unroll") for (int j = 0; j < 4; ++j) \
        __builtin_amdgcn_global_load_lds((const unsigned*)(W + woff[j] + (size_t)(kt_) * 64), (LASP unsigned*)(lbase + (unsigned)(st_) * 32768u + (unsigned)wid * 4096u + (unsigned)j * 1024u), 16, 0, 0); \
        __builtin_amdgcn_global_load_lds((const unsigned*)(A + aoff + (size_t)(kt_) * 64), (LASP unsigned*)(lbase + (unsigned)(st_) * 32768u + 16384u + (unsigned)wid * 1024u), 16, 0, 0); } while (0)
    const int r16 = lane & 15, q = lane >> 4, sw = r16 >> 1;
    const int base_w = (wid * 32 + r16) * 128, base_a = 16384 + r16 * 128;
    const int nk = K >> 6;
    GS_DMA(0, 0);
    asm volatile("s_waitcnt vmcnt(0)" ::: "memory");
    __syncthreads();
    for (int kt = 0; kt < nk; ++kt) {
        const int st = kt & 1;
        if (kt + 1 < nk) GS_DMA(kt + 1, st ^ 1);
        const unsigned char* sb = lds + st * 32768;
#pragma unroll
        for (int ks = 0; ks < 2; ++ks) {
            const int pos = ((ks * 4 + q) ^ sw) * 16;
            bf16x8 fa[2], fb[2];
#pragma unroll
            for (int i = 0; i < 2; ++i) { fa[i] = *(const bf16x8*)(sb + base_w + i * 2048 + pos); fb[i] = *(const bf16x8*)(sb + base_a + i * 2048 + pos); }
#pragma unroll
            for (int ni = 0; ni < 2; ++ni)
#pragma unroll
                for (int ti = 0; ti < 2; ++ti) acc[ni][ti] = __builtin_amdgcn_mfma_f32_16x16x32_bf16(fa[ni], fb[ti], acc[ni][ti], 0, 0, 0);
        }
        asm volatile("s_waitcnt vmcnt(0)" ::: "memory");
        __syncthreads();
    }
#undef GS_DMA
#pragma unroll
    for (int ti = 0; ti < 2; ++ti) { bf16_t* row = O + (size_t)(t0 + ti * 16 + r16) * ldo + n0 + wid * 32 + 4 * q;
#pragma unroll
        for (int ni = 0; ni < 2; ++ni) store4(row + ni * 16, acc[ni][ti]); }
}
__device__ __forceinline__ void gemm_phase_n1024(unsigned char* lds, const bf16_t* W, int ldw, const bf16_t* A, int lda, int K, bool with_ctx, bf16_t* O);

template <class Epi>
__device__ __forceinline__ void gemm_phase(unsigned char* lds, const bf16_t* W, int ldw, const bf16_t* A, int lda, int K, int ntt, int nn, const Epi& epi) {
    const int x = blockIdx.x & 7, j = blockIdx.x >> 3, stride = gridDim.x >> 3;
    const int ntx = (ntt - x + 7) >> 3;
    const int total = ntx * nn;
    for (int i = j; i < total; i += stride) {
        int tg = 0, rem = i;
        for (;;) { const int tc = min(8, ntx - 8 * tg); if (rem < tc * nn) break; rem -= tc * nn; ++tg; }
        const int tc = min(8, ntx - 8 * tg);
        const int ng = rem / (tc * 8), r2 = rem - ng * tc * 8;
        const int nl = r2 / tc, tl = r2 - nl * tc;
        const int nt = ng * 8 + nl, tt = (tg * 8 + tl) * 8 + x;
        gemm_tile(lds, W, ldw, A, lda, K, nt * 128, tt * 128, epi);
    }
}

__device__ __forceinline__ void store4(bf16_t* dst, const f32x4& v) { u32x2 w; w.x = pk_bf16(v[0], v[1]); w.y = pk_bf16(v[2], v[3]); *(u32x2*)dst = w; }
__device__ __forceinline__ float quad_sum(float v) { v += __shfl_xor(v, 16); v += __shfl_xor(v, 32); return v; }
__device__ __forceinline__ float sumsq4(const f32x4& v) { return v[0] * v[0] + v[1] * v[1] + v[2] * v[2] + v[3] * v[3]; }
__device__ __forceinline__ void rope4(f32x4& x1, f32x4& x2, const float* cs) {
    const f32x4 c01 = *(const f32x4*)cs, c23 = *(const f32x4*)(cs + 4);
    const f32x4 cc = {c01[0], c01[2], c23[0], c23[2]}, sn = {c01[1], c01[3], c23[1], c23[3]};
    const f32x4 a = x1 * cc - x2 * sn, b = x2 * cc + x1 * sn; x1 = a; x2 = b;
}

struct EpiInProj {
    const Params* pp; int l;
    __device__ __forceinline__ void operator()(f32x4 (&acc)[4][4], int nb0, int tb0, int lane) const {
        const Params& p = *pp; const int q = lane >> 4, r16 = lane & 15;
#pragma unroll
        for (int ti = 0; ti < 4; ++ti) {
            const int t = tb0 + ti * 16 + r16; int b, j; tok_decode(t, b, j); const bool lat = j < SEQ;
            if (nb0 < 384) {
                float ss = 0.f;
#pragma unroll
                for (int ni = 0; ni < 4; ++ni) { ss += sumsq4(acc[ni][ti]); store4(p.qkva + (size_t)t * 384 + nb0 + ni * 16 + 4 * q, acc[ni][ti]); }
                ss = quad_sum(ss);
                if (q == 0) p.ssq[(size_t)t * 8 + (nb0 >> 6)] = ss;
            } else if (nb0 < 896) {
                const bool isq = nb0 < 640;
#pragma unroll
                for (int mp = 0; mp < 2; ++mp) { f32x4 x1 = acc[2 * mp][ti], x2 = acc[2 * mp + 1][ti];
                    if (lat) rope4(x1, x2, p.cs16 + ((size_t)j * 16 + 4 * q) * 2);
                    if (isq) { x1 *= DIFF_SC; x2 *= DIFF_SC; }
                    const int map = ((nb0 - (isq ? 384 : 640)) >> 5) + mp;
                    bf16_t* dst = (isq ? p.Qd : p.Kd) + ((size_t)(b * 8 + map) * NKEY + j) * 32 + 4 * q;
                    store4(dst, x1); store4(dst + 16, x2); }
            } else if (nb0 < 1152 || (nb0 >= 1792 && nb0 < 1920)) {
                const bool isd = nb0 < 1152; const int hd = isd ? (nb0 - 896) >> 6 : (nb0 - 1792) >> 6;
                bf16_t* base = (isd ? p.VdT + (size_t)(b * 4 + hd) * 64 * NKEY : p.VgT + (size_t)(b * 2 + hd) * 64 * NKEY) + j;
#pragma unroll
                for (int ni = 0; ni < 4; ++ni)
#pragma unroll
                    for (int e = 0; e < 4; ++e) base[(size_t)(ni * 16 + 4 * q + e) * NKEY] = (bf16_t)(pk_bf16(acc[ni][ti][e], 0.f) & 0xffffu);
            } else if (nb0 < 1792) {
                const bool isq = nb0 < 1664; const int head = isq ? (nb0 - 1152) >> 6 : (nb0 - 1664) >> 6;
                const float* g = (isq ? p.g_gqa_q : p.g_gqa_k) + l * 64;
                float ss = 0.f;
#pragma unroll
                for (int ni = 0; ni < 4; ++ni) ss += sumsq4(acc[ni][ti]);
                ss = quad_sum(ss);
                const float rinv = frsq(ss * (1.f / 64.f) + EPS);
                bf16_t* dst = (isq ? p.Qg + ((size_t)(b * 8 + head) * NKEY + j) * 64 : p.Kg + ((size_t)(b * 2 + head) * NKEY + j) * 64);
#pragma unroll
                for (int mp = 0; mp < 2; ++mp) { const int d0 = mp * 16 + 4 * q;
                    f32x4 x1 = acc[mp][ti] * rinv * *(const f32x4*)(g + d0), x2 = acc[mp + 2][ti] * rinv * *(const f32x4*)(g + 32 + d0);
                    if (lat) rope4(x1, x2, p.cs32 + ((size_t)j * 32 + d0) * 2);
                    if (isq) { x1 *= GQA_SC; x2 *= GQA_SC; }
                    store4(dst + d0, x1); store4(dst + 32 + d0, x2); }
            } else if (nb0 == 1920) {
                f32x4 x1 = acc[0][ti], x2 = acc[1][ti];
                if (lat) rope4(x1, x2, p.cs16 + ((size_t)j * 16 + 4 * q) * 2);
#pragma unroll
                for (int hh = 0; hh < 4; ++hh) { bf16_t* dst = p.Km + ((size_t)(b * 4 + hh) * NKEY + j) * 96 + 64 + 4 * q; store4(dst, x1); store4(dst + 16, x2); }
            }
        }
    }
};

struct EpiMlaQ {
    const Params* pp;
    __device__ __forceinline__ void operator()(f32x4 (&acc)[4][4], int nb0, int tb0, int lane) const {
        const Params& p = *pp; const int q = lane >> 4, r16 = lane & 15;
#pragma unroll
        for (int ti = 0; ti < 4; ++ti) {
            const int t = tb0 + ti * 16 + r16; int b, j; tok_decode(t, b, j); const bool lat = j < SEQ;
            const f32x4 s4 = *(const f32x4*)(p.ssq + (size_t)t * 8);
            const float rq = frsq((s4[0] + s4[1] + s4[2] + s4[3]) * (1.f / 256.f) + EPS) * MLA_SC;
#pragma unroll
            for (int ni = 0; ni < 4; ++ni) {
                const int k16 = (nb0 >> 4) + ni, head = k16 / 6, part = k16 - head * 6;
                bf16_t* dst = p.Qm + ((size_t)(b * 4 + head) * NKEY + j) * 96 + part * 16 + 4 * q;
                if (part < 4) store4(dst, acc[ni][ti] * rq);
                else if (part == 4) { if (ni < 3) { f32x4 x1 = acc[ni][ti] * rq, x2 = acc[ni < 3 ? ni + 1 : ni][ti] * rq;
                    if (lat) rope4(x1, x2, p.cs16 + ((size_t)j * 16 + 4 * q) * 2);
                    store4(dst, x1); store4(dst + 16, x2); } }
            }
        }
    }
};
struct EpiMlaKV {
    const Params* pp;
    __device__ __forceinline__ void operator()(f32x4 (&acc)[4][4], int nb0, int tb0, int lane) const {
        const Params& p = *pp; const int q = lane >> 4, r16 = lane & 15;
        const int head = nb0 >> 7; const bool isv = (nb0 & 64) != 0;
#pragma unroll
        for (int ti = 0; ti < 4; ++ti) {
            const int t = tb0 + ti * 16 + r16; int b, j; tok_decode(t, b, j);
            const float rkv = frsq((p.ssq[(size_t)t * 8 + 4] + p.ssq[(size_t)t * 8 + 5]) * (1.f / 128.f) + EPS);
#pragma unroll
            for (int ni = 0; ni < 4; ++ni) {
                if (!isv) store4(p.Km + ((size_t)(b * 4 + head) * NKEY + j) * 96 + ni * 16 + 4 * q, acc[ni][ti] * rkv);
                else { bf16_t* base = p.VmT + (size_t)(b * 4 + head) * 64 * NKEY + j;
#pragma unroll
                    for (int e = 0; e < 4; ++e) base[(size_t)(ni * 16 + 4 * q + e) * NKEY] = (bf16_t)(pk_bf16(acc[ni][ti][e] * rkv, 0.f) & 0xffffu); }
            }
        }
    }
};
struct EpiBf16Out {
    bf16_t* O; int ldo;
    __device__ __forceinline__ void operator()(f32x4 (&acc)[4][4], int nb0, int tb0, int lane) const {
        const int q = lane >> 4, r16 = lane & 15;
#pragma unroll
        for (int ti = 0; ti < 4; ++ti) { bf16_t* row = O + (size_t)(tb0 + ti * 16 + r16) * ldo + nb0 + 4 * q;
#pragma unroll
            for (int ni = 0; ni < 4; ++ni) store4(row + ni * 16, acc[ni][ti]); }
    }
};
__device__ __forceinline__ void gemm_phase_n1024(unsigned char* lds, const bf16_t* W, int ldw, const bf16_t* A, int lda, int K, bool with_ctx, bf16_t* O) {
    EpiBf16Out e{O, DM};
    gemm_phase(lds, W, ldw, A, lda, K, NLAT / 128, 8, e);
    if (with_ctx) {
        if (gridDim.x == 512) {
            if (((blockIdx.x >> 3) & 3) == 0) { const int u = (blockIdx.x >> 5) * 8 + (blockIdx.x & 7); gemm_tile_small(lds, W, ldw, A, lda, K, (u & 7) * 128, NLAT + (u >> 3) * 32, O, DM); }
        } else for (int u = blockIdx.x; u < 128; u += gridDim.x) gemm_tile_small(lds, W, ldw, A, lda, K, (u & 7) * 128, NLAT + (u >> 3) * 32, O, DM);
    }
}
struct EpiSwiglu {
    bf16_t* G;
    __device__ __forceinline__ void operator()(f32x4 (&acc)[4][4], int nb0, int tb0, int lane) const {
        const int q = lane >> 4, r16 = lane & 15;
#pragma unroll
        for (int ti = 0; ti < 4; ++ti) { bf16_t* row = G + (size_t)(tb0 + ti * 16 + r16) * FFN + ((nb0 >> 5) * 16) + 4 * q;
#pragma unroll
            for (int mp = 0; mp < 2; ++mp) { f32x4 a;
#pragma unroll
                for (int e = 0; e < 4; ++e) { const float g = acc[2 * mp][ti][e], u = acc[2 * mp + 1][ti][e]; a[e] = g * __builtin_amdgcn_rcpf(1.f + fexp2(-g * LOG2E)) * u; }
                store4(row + mp * 16, a); } }
    }
};

template <int DQK>
__device__ __forceinline__ void attn_pipe(unsigned char* lds, const bf16_t* __restrict__ Qw, const bf16_t* __restrict__ Kh, const bf16_t* __restrict__ VTh, int kt0, int kt1, f32x16 (&O)[2], float& lfin) {
    constexpr int KMAIN = DQK >= 64 ? 8192 : 4096, KROPE = DQK == 96 ? 4096 : 0, VOFF = KMAIN + KROPE, STG = VOFF + 8192;
    constexpr int NPW = DQK == 96 ? 5 : (DQK == 64 ? 4 : 3);
    static_assert(3 * STG <= LDS_BYTES, "three stages must fit");
    const int tid = otid(), lane = tid & 63, wid = tid >> 6, h = lane >> 5, lr = lane & 31;
    const int pr = (lr & ~12) | ((lr & 4) << 1) | ((lr & 8) >> 1);
    bf16x8 qf[DQK / 16];
#pragma unroll
    for (int ks = 0; ks < DQK / 16; ++ks) qf[ks] = *(const bf16x8*)(Qw + (size_t)lr * DQK + ks * 16 + 8 * h);
#pragma unroll
    for (int r = 0; r < 16; ++r) { O[0][r] = 0.f; O[1][r] = 0.f; }
    float m = 0.f, lsum = 0.f; bool has_ref = false;
    const int n = kt1 - kt0;
    unsigned soff[NPW], doff[NPW];
    {
        const int r8 = lane >> 3, p8 = lane & 7, r4 = lane >> 2, p4 = lane & 3;
        if (DQK >= 64) {
#pragma unroll
            for (int i = 0; i < 2; ++i) { const int g = wid + 4 * i, row = 8 * g + r8; soff[i] = (unsigned)(row * DQK + (p8 ^ ((row >> 1) & 7)) * 8); doff[i] = (unsigned)(g * 1024); }
            if (DQK == 96) { const int row = 16 * wid + r4; soff[2] = (unsigned)(row * DQK + 64 + (p4 ^ ((row >> 2) & 3)) * 8); doff[2] = (unsigned)(KMAIN + wid * 1024); }
        } else { const int row = 16 * wid + r4; soff[0] = (unsigned)(row * DQK + (p4 ^ ((row >> 2) & 3)) * 8); doff[0] = (unsigned)(wid * 1024); }
#pragma unroll
        for (int i = 0; i < 2; ++i) { const int g = wid + 4 * i, row = 8 * g + r8; soff[NPW - 2 + i] = (unsigned)(row * NKEY + (p8 ^ ((row >> 1) & 7)) * 8); doff[NPW - 2 + i] = (unsigned)(VOFF + g * 1024); }
    }
    const unsigned lbase = (unsigned)(size_t)lds;
#define AP_DMA(kt_, off_) do { \
        _Pragma("unroll") for (int i = 0; i < NPW - 2; ++i) __builtin_amdgcn_global_load_lds((const unsigned*)(Kh + (size_t)(kt_) * 64 * DQK + soff[i]), (LASP unsigned*)(lbase + (unsigned)(off_) + doff[i]), 16, 0, 0); \
        _Pragma("unroll") for (int i = NPW - 2; i < NPW; ++i) __builtin_amdgcn_global_load_lds((const unsigned*)(VTh + (size_t)(kt_) * 64 + soff[i]), (LASP unsigned*)(lbase + (unsigned)(off_) + doff[i]), 16, 0, 0); } while (0)
    const int swk = (pr >> 1) & 7, swr = (pr >> 2) & 3, swv = (lr >> 1) & 7;
#define AP_KADDR(ks_) (DQK >= 64 ? ((ks_) < 4 ? pr * 128 + (((ks_) * 2 + h) ^ swk) * 16 : KMAIN + pr * 64 + ((((ks_) - 4) * 2 + h) ^ swr) * 16) : pr * 64 + (((ks_) * 2 + h) ^ swr) * 16)
#define AP_KROW32(ks_) ((DQK >= 64 && (ks_) < 4) ? 32 * 128 : 32 * 64)
#define AP_QKCHAIN(Sx0, Sx1, kb_) do { _Pragma("unroll") for (int ks = 0; ks < DQK / 16; ++ks) { \
            const bf16x8 k0_ = *(const bf16x8*)((kb_) + AP_KADDR(ks)), k1_ = *(const bf16x8*)((kb_) + AP_KADDR(ks) + AP_KROW32(ks)); \
            Sx0 = __builtin_amdgcn_mfma_f32_32x32x16_bf16(k0_, qf[ks], Sx0, 0, 0, 0); Sx1 = __builtin_amdgcn_mfma_f32_32x32x16_bf16(k1_, qf[ks], Sx1, 0, 0, 0); } } while (0)
#define AP_QK(Sx0, Sx1, off_) do { const unsigned char* kbq_ = lds + (off_); \
        if (has_ref) { const float ni_ = -m; _Pragma("unroll") for (int r = 0; r < 16; ++r) { Sx0[r] = ni_; Sx1[r] = ni_; } AP_QKCHAIN(Sx0, Sx1, kbq_); } \
        else { _Pragma("unroll") for (int r = 0; r < 16; ++r) { Sx0[r] = 0.f; Sx1[r] = 0.f; } AP_QKCHAIN(Sx0, Sx1, kbq_); } } while (0)
#define AP_BODY(t_, Sc0, Sc1, Sn0, Sn1, DMA_, NXT_) do { \
        constexpr bool nxt_ = NXT_; \
        if (DMA_) AP_DMA(kt0 + (t_) + 2, ow); \
        if (nxt_) AP_QK(Sn0, Sn1, ok); \
        if (((t_) & 3) == 0) {   \
        const float seed_ = fmaxf(Sc0[15], Sc1[15]); \
        float mxa_ = max3f(seed_, Sc0[0], Sc0[1]), mxb_ = max3f(seed_, Sc1[0], Sc1[1]); \
        _Pragma("unroll") for (int r = 2; r < 14; r += 2) { mxa_ = max3f(mxa_, Sc0[r], Sc0[r + 1]); mxb_ = max3f(mxb_, Sc1[r], Sc1[r + 1]); } \
        float mx_ = max3f(mxa_, mxb_, Sc0[14]); mx_ = max3f(mx_, Sc1[14], mx_); mx_ = xhalf_max(mx_); \
        const bool first_ = (t_) == 0; \
        if (__any(mx_ > 40.f || (first_ && mx_ < -40.f))) { \
            const float dm_ = (mx_ > 40.f || (first_ && mx_ < -40.f)) ? mx_ : 0.f; \
            if (!first_) { const float al_ = fexp2(-dm_); lsum *= al_; _Pragma("unroll") for (int r = 0; r < 16; ++r) { O[0][r] *= al_; O[1][r] *= al_; } } \
            m += dm_; has_ref = true; \
            _Pragma("unroll") for (int r = 0; r < 16; ++r) { Sc0[r] -= dm_; Sc1[r] -= dm_; } \
            if (nxt_) { _Pragma("unroll") for (int r = 0; r < 16; ++r) { Sn0[r] -= dm_; Sn1[r] -= dm_; } } \
        } } \
        float ps_ = 0.f, pt_ = 0.f; \
        _Pragma("unroll") for (int r = 0; r < 16; ++r) { Sc0[r] = fexp2(Sc0[r]); Sc1[r] = fexp2(Sc1[r]); ps_ += Sc0[r]; pt_ += Sc1[r]; } \
        lsum += ps_ + pt_; \
        u32x4 pw_[4]; \
        _Pragma("unroll") for (int q = 0; q < 2; ++q) { const int o = q * 8; \
            pw_[q].x = pk_bf16(Sc0[o], Sc0[o + 1]); pw_[q].y = pk_bf16(Sc0[o + 2], Sc0[o + 3]); pw_[q].z = pk_bf16(Sc0[o + 4], Sc0[o + 5]); pw_[q].w = pk_bf16(Sc0[o + 6], Sc0[o + 7]); \
            pw_[2 + q].x = pk_bf16(Sc1[o], Sc1[o + 1]); pw_[2 + q].y = pk_bf16(Sc1[o + 2], Sc1[o + 3]); pw_[2 + q].z = pk_bf16(Sc1[o + 4], Sc1[o + 5]); pw_[2 + q].w = pk_bf16(Sc1[o + 6], Sc1[o + 7]); } \
        { const unsigned char* vb_ = lds + ov + VOFF + lr * 128; \
          _Pragma("unroll") for (int ksp = 0; ksp < 4; ++ksp) { const int vp_ = ((ksp * 2 + h) ^ swv) * 16; const bf16x8 v0_ = *(const bf16x8*)(vb_ + vp_), v1_ = *(const bf16x8*)(vb_ + 32 * 128 + vp_); const bf16x8 pc_ = __builtin_bit_cast(bf16x8, pw_[ksp]); \
              O[0] = __builtin_amdgcn_mfma_f32_32x32x16_bf16(v0_, pc_, O[0], 0, 0, 0); O[1] = __builtin_amdgcn_mfma_f32_32x32x16_bf16(v1_, pc_, O[1], 0, 0, 0); } } \
        asm volatile("s_waitcnt vmcnt(0)" ::: "memory");     \
        __syncthreads(); \
        { const int tmp_ = ov; ov = ok; ok = ow; ow = tmp_; } } while (0)
    int ov = 0, ok = STG, ow = 2 * STG;
    f32x16 Sa0, Sa1, Sb0, Sb1;
    AP_DMA(kt0, 0); AP_DMA(kt0 + 1, STG);
    asm volatile("s_waitcnt vmcnt(0)" ::: "memory");
    __syncthreads();
    AP_QK(Sa0, Sa1, 0);
    int t = 0;
    for (; t < n - 2; t += 2) {
        AP_BODY(t, Sa0, Sa1, Sb0, Sb1, true, true);
        AP_BODY(t + 1, Sb0, Sb1, Sa0, Sa1, true, true);
    }
    AP_BODY(t, Sa0, Sa1, Sb0, Sb1, false, true);
    AP_BODY(t + 1, Sb0, Sb1, Sa0, Sa1, false, false);
#undef AP_DMA
#undef AP_KADDR
#undef AP_KROW32
#undef AP_QKCHAIN
#undef AP_QK
#undef AP_BODY
    lfin = xhalf_sum(lsum);
}

__device__ __forceinline__ void attn_gqa2(unsigned char* lds, const bf16_t* __restrict__ Qw, const bf16_t* __restrict__ Kh, const bf16_t* __restrict__ VTh, int kt0, int kt1, f32x16 (&O)[2][2], float (&lfin)[2]) {
    constexpr int DQK = 64, VOFF = 8192, STG = 16384;
    const int tid = otid(), lane = tid & 63, wid = tid >> 6, h = lane >> 5, lr = lane & 31;
    const int pr = (lr & ~12) | ((lr & 4) << 1) | ((lr & 8) >> 1);
    bf16x8 qf[2][4];
#pragma unroll
    for (int c = 0; c < 2; ++c)
#pragma unroll
        for (int ks = 0; ks < 4; ++ks) qf[c][ks] = *(const bf16x8*)(Qw + (size_t)(c * 32 + lr) * DQK + ks * 16 + 8 * h);
#pragma unroll
    for (int c = 0; c < 2; ++c)
#pragma unroll
        for (int r = 0; r < 16; ++r) { O[c][0][r] = 0.f; O[c][1][r] = 0.f; }
    float m[2] = {0.f, 0.f}, lsum[2] = {0.f, 0.f}; bool has_ref = false;
    const int n = kt1 - kt0;
    unsigned soff[4], doff[4];
    { const int r8 = lane >> 3, p8 = lane & 7;
#pragma unroll
      for (int i = 0; i < 2; ++i) { const int g = wid + 4 * i, row = 8 * g + r8, c = p8 ^ ((row >> 1) & 7);
          soff[i] = (unsigned)(row * DQK + c * 8); doff[i] = (unsigned)(g * 1024); soff[2 + i] = (unsigned)(row * NKEY + c * 8); doff[2 + i] = (unsigned)(VOFF + g * 1024); } }
    const unsigned lbase = (unsigned)(size_t)lds;
#define G2_DMA(kt_, off_) do { \
        _Pragma("unroll") for (int i = 0; i < 2; ++i) __builtin_amdgcn_global_load_lds((const unsigned*)(Kh + (size_t)(kt_) * 64 * DQK + soff[i]), (LASP unsigned*)(lbase + (unsigned)(off_) + doff[i]), 16, 0, 0); \
        _Pragma("unroll") for (int i = 2; i < 4; ++i) __builtin_amdgcn_global_load_lds((const unsigned*)(VTh + (size_t)(kt_) * 64 + soff[i]), (LASP unsigned*)(lbase + (unsigned)(off_) + doff[i]), 16, 0, 0); } while (0)
    const int swk = (pr >> 1) & 7, swv = (lr >> 1) & 7;
    G2_DMA(kt0, 0);
    asm volatile("s_waitcnt vmcnt(0)" ::: "memory");
    __syncthreads();
    for (int t = 0; t < n; ++t) {
        const int so = (t & 1) * STG;
        if (t + 1 < n) G2_DMA(kt0 + t + 1, STG - so);
        const bool chk = (t & 3) == 0, first = t == 0;
        u32x4 pw[2][4];
        f32x16 S[2][2];
#define G2_QK2() do { const unsigned char* kb = lds + so + pr * 128; _Pragma("unroll") for (int ks = 0; ks < 4; ++ks) { const int kp = ((ks * 2 + h) ^ swk) * 16; \
            const bf16x8 k0 = *(const bf16x8*)(kb + kp), k1 = *(const bf16x8*)(kb + 32 * 128 + kp); \
            S[0][0] = __builtin_amdgcn_mfma_f32_32x32x16_bf16(k0, qf[0][ks], S[0][0], 0, 0, 0); S[0][1] = __builtin_amdgcn_mfma_f32_32x32x16_bf16(k1, qf[0][ks], S[0][1], 0, 0, 0); \
            S[1][0] = __builtin_amdgcn_mfma_f32_32x32x16_bf16(k0, qf[1][ks], S[1][0], 0, 0, 0); S[1][1] = __builtin_amdgcn_mfma_f32_32x32x16_bf16(k1, qf[1][ks], S[1][1], 0, 0, 0); } } while (0)
        if (has_ref) {
#pragma unroll
            for (int c = 0; c < 2; ++c) { const float ni = -m[c];
#pragma unroll
                for (int r = 0; r < 16; ++r) { S[c][0][r] = ni; S[c][1][r] = ni; } }
            G2_QK2();
        } else {
#pragma unroll
            for (int c = 0; c < 2; ++c)
#pragma unroll
                for (int r = 0; r < 16; ++r) { S[c][0][r] = 0.f; S[c][1][r] = 0.f; }
            G2_QK2();
        }
#undef G2_QK2
        __builtin_amdgcn_sched_group_barrier(0x100, 8, 0);
        __builtin_amdgcn_sched_group_barrier(0x008, 16, 0);
        __builtin_amdgcn_sched_barrier(0);
        bf16x8 vf[8];
#pragma unroll
        for (int c = 0; c < 2; ++c) {
            if (chk) {
                const float seed = fmaxf(S[c][0][15], S[c][1][15]);
                float mxa = max3f(seed, S[c][0][0], S[c][0][1]), mxb = max3f(seed, S[c][1][0], S[c][1][1]);
#pragma unroll
                for (int r = 2; r < 14; r += 2) { mxa = max3f(mxa, S[c][0][r], S[c][0][r + 1]); mxb = max3f(mxb, S[c][1][r], S[c][1][r + 1]); }
                float mx = max3f(mxa, mxb, S[c][0][14]); mx = max3f(mx, S[c][1][14], mx);
                if (__any(first || mx > 40.f)) {
                    const float mq = xhalf_max(mx);
                    const float dm = (mq > 40.f || (first && mq < -40.f)) ? mq : 0.f;
                    if (!first) { const float al = fexp2(-dm); lsum[c] *= al;
#pragma unroll
                        for (int r = 0; r < 16; ++r) { O[c][0][r] *= al; O[c][1][r] *= al; } }
                    m[c] += dm; has_ref = true;
#pragma unroll
                    for (int r = 0; r < 16; ++r) { S[c][0][r] -= dm; S[c][1][r] -= dm; }
                }
            }
            float ps = 0.f, pt = 0.f;
#pragma unroll
            for (int r = 0; r < 16; ++r) { S[c][0][r] = fexp2(S[c][0][r]); S[c][1][r] = fexp2(S[c][1][r]); ps += S[c][0][r]; pt += S[c][1][r]; }
            lsum[c] += ps + pt;
#pragma unroll
            for (int q2 = 0; q2 < 2; ++q2) { const int o = q2 * 8;
                pw[c][q2].x = pk_bf16(S[c][0][o], S[c][0][o + 1]); pw[c][q2].y = pk_bf16(S[c][0][o + 2], S[c][0][o + 3]); pw[c][q2].z = pk_bf16(S[c][0][o + 4], S[c][0][o + 5]); pw[c][q2].w = pk_bf16(S[c][0][o + 6], S[c][0][o + 7]);
                pw[c][2 + q2].x = pk_bf16(S[c][1][o], S[c][1][o + 1]); pw[c][2 + q2].y = pk_bf16(S[c][1][o + 2], S[c][1][o + 3]); pw[c][2 + q2].z = pk_bf16(S[c][1][o + 4], S[c][1][o + 5]); pw[c][2 + q2].w = pk_bf16(S[c][1][o + 6], S[c][1][o + 7]); }
            __builtin_amdgcn_sched_barrier(0);
            if (c == 0) { const unsigned char* vb = lds + so + VOFF + lr * 128;
#pragma unroll
                for (int ksp = 0; ksp < 4; ++ksp) { const int vp = ((ksp * 2 + h) ^ swv) * 16; vf[2 * ksp] = *(const bf16x8*)(vb + vp); vf[2 * ksp + 1] = *(const bf16x8*)(vb + 32 * 128 + vp); }
                __builtin_amdgcn_sched_barrier(0); }
        }
        {
#pragma unroll
          for (int ksp = 0; ksp < 4; ++ksp) {
              const bf16x8 v0 = vf[2 * ksp], v1 = vf[2 * ksp + 1];
              const bf16x8 p0 = __builtin_bit_cast(bf16x8, pw[0][ksp]), p1 = __builtin_bit_cast(bf16x8, pw[1][ksp]);
              O[0][0] = __builtin_amdgcn_mfma_f32_32x32x16_bf16(v0, p0, O[0][0], 0, 0, 0); O[0][1] = __builtin_amdgcn_mfma_f32_32x32x16_bf16(v1, p0, O[0][1], 0, 0, 0);
              O[1][0] = __builtin_amdgcn_mfma_f32_32x32x16_bf16(v0, p1, O[1][0], 0, 0, 0); O[1][1] = __builtin_amdgcn_mfma_f32_32x32x16_bf16(v1, p1, O[1][1], 0, 0, 0); } }
        asm volatile("s_waitcnt vmcnt(0)" ::: "memory");
        __syncthreads();
    }
#undef G2_DMA
    lfin[0] = xhalf_sum(lsum[0]); lfin[1] = xhalf_sum(lsum[1]);
}

__device__ __forceinline__ void store_o(bf16_t* yrow  , const f32x16 (&O)[2], int h) {
#pragma unroll
    for (int mb = 0; mb < 2; ++mb)
#pragma unroll
        for (int q4 = 0; q4 < 4; ++q4) { u32x2 w; w.x = pk_bf16(O[mb][q4 * 4], O[mb][q4 * 4 + 1]); w.y = pk_bf16(O[mb][q4 * 4 + 2], O[mb][q4 * 4 + 3]); *(u32x2*)(yrow + mb * 32 + q4 * 8 + 4 * h) = w; }
}

__device__ __forceinline__ int tok_row(int b, int qrow) { return qrow < SEQ ? b * SEQ + qrow : NLAT + b * CTXL + (qrow - SEQ); }
__device__ __forceinline__ void attn_unit(unsigned char* lds, const Params& p, int l, int type, int b, int head, int qb) {
    const int tid = otid(), lane = tid & 63, wid = tid >> 6, h = lane >> 5, lr = lane & 31;
    const int kt0 = qb < 64 ? 0 : 128, kt1 = 132;
    const int qrow0 = qb * 128 + wid * 32;
    bf16_t* y = p.hbuf + (size_t)tok_row(b, qrow0 + lr) * DM;
    f32x16 O[2]; float lf;
    if (type == 0) {
        const size_t hb = (size_t)(b * 4 + head);
        attn_pipe<96>(lds, p.Qm + (hb * NKEY + qrow0) * 96, p.Km + hb * NKEY * 96, p.VmT + hb * 64 * NKEY, kt0, kt1, O, lf);
        const float inv = 1.f / lf;
#pragma unroll
        for (int r = 0; r < 16; ++r) { O[0][r] *= inv; O[1][r] *= inv; }
        store_o(y + head * 64, O, h);
    } else if (type == 2) {
        const int kt0g = qb < 32 ? 0 : 128, qrow0g = qb * 256 + wid * 64;
        const size_t hq = (size_t)(b * 8 + head), hk = (size_t)(b * 2 + (head >> 2));
        f32x16 O2[2][2]; float lf2[2];
        attn_gqa2(lds, p.Qg + (hq * NKEY + qrow0g) * 64, p.Kg + hk * NKEY * 64, p.VgT + hk * 64 * NKEY, kt0g, kt1, O2, lf2);
#pragma unroll
        for (int c = 0; c < 2; ++c) { const float inv = 1.f / lf2[c];
#pragma unroll
            for (int r = 0; r < 16; ++r) { O2[c][0][r] *= inv; O2[c][1][r] *= inv; }
            store_o(p.hbuf + (size_t)tok_row(b, qrow0g + c * 32 + lr) * DM + 512 + head * 64, O2[c], h); }
    } else {
        f32x16 O1[2];
        const size_t m0 = (size_t)(b * 8 + 2 * head) * NKEY, m1 = m0 + NKEY;
        attn_pipe<32>(lds, p.Qd + (m0 + qrow0) * 32, p.Kd + m0 * 32, p.VdT + (size_t)(b * 4 + head) * 64 * NKEY, kt0, kt1, O1, lf);
        const float inv1 = 1.f / lf;
#pragma unroll
        for (int r = 0; r < 16; ++r) { O1[0][r] *= inv1; O1[1][r] *= inv1; }
        attn_pipe<32>(lds, p.Qd + (m1 + qrow0) * 32, p.Kd + m1 * 32, p.VdT + (size_t)(b * 4 + head) * 64 * NKEY, kt0, kt1, O, lf);
        const float inv2 = p.lam[l] / lf;
        float ss = 0.f;
#pragma unroll
        for (int r = 0; r < 16; ++r) { O[0][r] = O1[0][r] - inv2 * O[0][r]; O[1][r] = O1[1][r] - inv2 * O[1][r]; ss += O[0][r] * O[0][r] + O[1][r] * O[1][r]; }
        ss = xhalf_sum(ss);
        const float lam_init = 0.8f - 0.6f * __expf(-0.3f * (float)l);
        const float rinv = frsq(ss * (1.f / 64.f) + EPS) * (1.f - lam_init);
        const float* g = p.g_diff_sub + l * 64;
#pragma unroll
        for (int mb = 0; mb < 2; ++mb)
#pragma unroll
            for (int q4 = 0; q4 < 4; ++q4) { const f32x4 gv = *(const f32x4*)(g + mb * 32 + q4 * 8 + 4 * h);
#pragma unroll
                for (int e = 0; e < 4; ++e) O[mb][q4 * 4 + e] *= rinv * gv[e]; }
        store_o(y + 256 + head * 64, O, h);
    }
}

__device__ __forceinline__ void attn_phase(unsigned char* lds, const Params& p, int l) {
    __shared__ int s_unit;
    const int qlen = 192 + (l == 0 ? 6 : 0);
    const int xcc = (int)(__builtin_amdgcn_s_getreg((3 << 11) | 20) & 7u);
    for (int xo = 0; xo < 8; ++xo) {
        const int q = (xcc + xo) & 7;
        unsigned* ctr = p.counters + l * 8 + q;
        for (;;) {
            if (otid() == 0) s_unit = (int)atomicAdd(ctr, 1u);
            __syncthreads();
            const int i = s_unit;
            __syncthreads();
            if (i >= qlen) break;
            int type, b, head, qb;
            if (i < 64) { type = 2; b = q >> 2; head = ((q >> 1) & 1) * 4 + (q & 1) * 2 + (i >> 5); qb = i & 31; }
            else if (i < 128) { type = 1; b = q >> 2; head = q & 3; qb = i - 64; }
            else if (i < 192) { type = 0; b = q >> 2; head = q & 3; qb = i - 128; }
            else { const int j = q * 6 + (i - 192);
                if (j < 16) { type = 2; b = j >> 3; head = j & 7; qb = 32; } else if (j < 32) { const int w = j - 16; type = 1; b = w >> 3; head = (w >> 1) & 3; qb = 64 + (w & 1); }
                else { const int w = j - 32; type = 0; b = w >> 3; head = (w >> 1) & 3; qb = 64 + (w & 1); } }
            attn_unit(lds, p, l, type, b, head, qb);
        }
    }
}

__device__ __forceinline__ void norm_store(const f32x4 (&v)[4], float ss, const float* g, const float* sc, const float* sh, bf16_t* hrow, int lane) {
    const float r = frsq(ss * (1.f / 1024.f) + EPS);
#pragma unroll
    for (int i = 0; i < 4; ++i) { const int c = i * 256 + lane * 4; const f32x4 gg = *(const f32x4*)(g + c), s1 = *(const f32x4*)(sc + c), s0 = *(const f32x4*)(sh + c);
        float o[4];
#pragma unroll
        for (int e = 0; e < 4; ++e) o[e] = v[i][e] * r * gg[e] * (1.f + s1[e]) + s0[e];
        u32x2 w; w.x = pk_bf16(o[0], o[1]); w.y = pk_bf16(o[2], o[3]); *(u32x2*)(hrow + c) = w; }
}
__device__ __forceinline__ void phase_prenorm0(const Params& p) {
    const int tid = otid(), lane = tid & 63, gw = blockIdx.x * 4 + (tid >> 6), nw = gridDim.x * 4;
    for (int row = gw; row < NT; row += nw) {
        const float* xr = xin_row(p, 0, row); f32x4 v[4]; float ss = 0.f;
#pragma unroll
        for (int i = 0; i < 4; ++i) { v[i] = *(const f32x4*)(xr + i * 256 + lane * 4); ss += v[i][0] * v[i][0] + v[i][1] * v[i][1] + v[i][2] * v[i][2] + v[i][3] * v[i][3]; }
        ss = wave_sum(ss);
        const float* m = p.mod + (size_t)mod_vec(row) * 6144;
        norm_store(v, ss, p.g_attn_pre, m + 1024, m, p.hbuf + (size_t)row * DM, lane);
    }
}
__device__ __forceinline__ void phase_rowupdate(const Params& p, int l, int which) {
    const int tid = otid(), lane = tid & 63, gw = blockIdx.x * 4 + (tid >> 6), nw = gridDim.x * 4;
    const bool last = l == DEPTH - 1; const int nrows = last ? NLAT : NT;
    for (int row = gw; row < nrows; row += nw) {
        const bf16_t* yr = (const bf16_t*)p.Yf + (size_t)row * DM; const float* xo = which == 0 ? xin_row(p, l, row) : xw_row(p, row); float* xn = xw_row(p, row);
        const float* m = p.mod + (size_t)(l * 3 + mod_vec(row)) * 6144;
        const float* gate = m + (which == 0 ? 2048 : 5120); const float* gp = (which == 0 ? p.g_attn_post : p.g_ffn_post) + l * DM;
        f32x4 y[4], x[4]; float ss = 0.f;
#pragma unroll
        for (int i = 0; i < 4; ++i) { const u32x2 yb = *(const u32x2*)(yr + i * 256 + lane * 4); y[i] = (f32x4){__uint_as_float(yb.x << 16), __uint_as_float(yb.x & 0xffff0000u), __uint_as_float(yb.y << 16), __uint_as_float(yb.y & 0xffff0000u)}; x[i] = *(const f32x4*)(xo + i * 256 + lane * 4); ss += y[i][0] * y[i][0] + y[i][1] * y[i][1] + y[i][2] * y[i][2] + y[i][3] * y[i][3]; }
        ss = wave_sum(ss);
        const float r = frsq(ss * (1.f / 1024.f) + EPS); float s2 = 0.f;
#pragma unroll
        for (int i = 0; i < 4; ++i) { const int c = i * 256 + lane * 4; const f32x4 gt = *(const f32x4*)(gate + c), gg = *(const f32x4*)(gp + c);
#pragma unroll
            for (int e = 0; e < 4; ++e) { x[i][e] += gt[e] * (y[i][e] * r * gg[e]); s2 += x[i][e] * x[i][e]; }
            *(f32x4*)(xn + c) = x[i]; }
        if (which == 0) { s2 = wave_sum(s2); norm_store(x, s2, p.g_ffn_pre + l * DM, m + 4096, m + 3072, p.hbuf + (size_t)row * DM, lane); }
        else if (!last) { s2 = wave_sum(s2); const float* m2 = p.mod + (size_t)((l + 1) * 3 + mod_vec(row)) * 6144; norm_store(x, s2, p.g_attn_pre + (l + 1) * DM, m2 + 1024, m2, p.hbuf + (size_t)row * DM, lane); }
    }
}

__device__ __forceinline__ void conv_tile(unsigned char* lds, const float* __restrict__ src, int K, int N, int kt, int nt, bf16_t* dst, int mode, const float* kscale) {
    float* tile = (float*)lds;
    const int tid = otid(), k0 = kt * 64, n0 = nt * 64;
#pragma unroll 4
    for (int i = 0; i < 16; ++i) { const int k = i * 4 + (tid >> 6), n = tid & 63; float v = 0.f; if (n0 + n < N) { v = src[(size_t)(k0 + k) * N + n0 + n]; if (kscale) v *= kscale[k0 + k]; } tile[k * 65 + n] = v; }
    __syncthreads();
#pragma unroll
    for (int jj = 0; jj < 2; ++jj) { const int c = tid + 256 * jj, n = c >> 3, kc = c & 7, ng = n0 + n;
        if (ng < N) { int row;
            if (mode == 1) row = ng < 384 ? ng : (ng < 416 ? ng + 1536 : ng - 32);
            else if (mode == 2) row = 32 * (ng >> 4) + (ng & 15);
            else if (mode == 3) row = 32 * (ng >> 4) + 16 + (ng & 15);
            else row = ng;
            float e[8];
#pragma unroll
            for (int q = 0; q < 8; ++q) e[q] = tile[(kc * 8 + q) * 65 + n];
            u32x4 w; w.x = pk_bf16(e[0], e[1]); w.y = pk_bf16(e[2], e[3]); w.z = pk_bf16(e[4], e[5]); w.w = pk_bf16(e[6], e[7]);
            *(u32x4*)(dst + (size_t)row * K + k0 + kc * 8) = w; } }
    __syncthreads();
}
__device__ __forceinline__ void sincos_d(double x, float& s, float& c) {
    const double n = rint(x * 0.63661977236758134308);
    double r = x - n * 1.57079632679489655800; r -= n * 6.12323399573676603587e-17;
    const double r2 = r * r;
    double sp = r * (1.0 + r2 * (-1.0 / 6 + r2 * (1.0 / 120 + r2 * (-1.0 / 5040 + r2 * (1.0 / 362880 + r2 * (-1.0 / 39916800 + r2 * (1.0 / 6227020800.0)))))));
    double cp = 1.0 + r2 * (-0.5 + r2 * (1.0 / 24 + r2 * (-1.0 / 720 + r2 * (1.0 / 40320 + r2 * (-1.0 / 3628800 + r2 * (1.0 / 479001600.0))))));
    const int q = ((int)n) & 3;
    const double ss = (q == 0) ? sp : (q == 1) ? cp : (q == 2) ? -sp : -cp;
    const double cc = (q == 0) ? cp : (q == 1) ? -sp : (q == 2) ? -cp : sp;
    s = (float)ss; c = (float)cc;
}
constexpr int CONV_PER_LAYER = 2904, N_CONV = 2 * CONV_PER_LAYER, N_ADA = 192, N_ROPE = 1536, N_PAD = 2;
__device__ __forceinline__ void phase_prologue(unsigned char* lds, const Params& p) {
    const int tid = otid();
    const int total = N_CONV + N_ADA + N_ROPE + N_PAD;
    for (int u = blockIdx.x; u < total; u += gridDim.x) {
        if (u < N_ADA) {
            const int wu = u * 4 + (tid >> 6), lane = tid & 63, l = wu / 384, rem = wu - l * 384, cc = rem >> 4, kc = rem & 15;
            const int col = cc * 256 + lane * 4; f32x4 a0 = {0, 0, 0, 0}, a1 = a0, a2 = a0;
            const float* wbase = p.w_ada + ((size_t)l * 1024 + kc * 64) * 6144 + col;
#pragma unroll 8
            for (int k = 0; k < 64; ++k) { const int kk = kc * 64 + k; const f32x4 w = *(const f32x4*)(wbase + (size_t)k * 6144);
                const float c0 = p.c[kk], c1 = p.c[1024 + kk], c2 = p.c_ctx[kk];
                const float s0 = c0 / (1.f + __expf(-c0)), s1 = c1 / (1.f + __expf(-c1)), s2 = c2 / (1.f + __expf(-c2));
                a0 += w * s0; a1 += w * s1; a2 += w * s2; }
            float* o = p.adapart + ((size_t)(l * 16 + kc) * 3) * 6144 + col;
            *(f32x4*)o = a0; *(f32x4*)(o + 6144) = a1; *(f32x4*)(o + 2 * 6144) = a2;
        } else if (u < N_ADA + N_CONV) {
            const int v = u - N_ADA, l = v / CONV_PER_LAYER, ti = v - l * CONV_PER_LAYER;
            if (ti < 496) conv_tile(lds, p.w_in + (size_t)l * 1024 * 1952, 1024, 1952, ti / 31, ti % 31, p.wt_in + (size_t)l * INW * 1024, 1, nullptr);
            else if (ti < 520) { const int q = ti - 496; conv_tile(lds, p.w_mla_qb + (size_t)l * 256 * 384, 256, 384, q / 6, q % 6, p.wt_qb + (size_t)l * 384 * 256, 0, p.g_mla_q + l * 256); }
            else if (ti < 536) { const int q = ti - 520; conv_tile(lds, p.w_mla_kvb + (size_t)l * 128 * 512, 128, 512, q / 8, q % 8, p.wt_kvb + (size_t)l * 512 * 128, 0, p.g_mla_kv + l * 128); }
            else if (ti < 792) { const int q = ti - 536; conv_tile(lds, p.w_out + (size_t)l * 1024 * 1024, 1024, 1024, q / 16, q % 16, p.wt_out + (size_t)l * 1024 * 1024, 0, nullptr); }
            else if (ti < 1496) { const int q = ti - 792; conv_tile(lds, p.w_gate + (size_t)l * 1024 * FFN, 1024, FFN, q / 44, q % 44, p.wt_gu + (size_t)l * 2 * FFN * 1024, 2, nullptr); }
            else if (ti < 2200) { const int q = ti - 1496; conv_tile(lds, p.w_up + (size_t)l * 1024 * FFN, 1024, FFN, q / 44, q % 44, p.wt_gu + (size_t)l * 2 * FFN * 1024, 3, nullptr); }
            else { const int q = ti - 2200; conv_tile(lds, p.w_down + (size_t)l * FFN * 1024, FFN, 1024, q / 16, q % 16, p.wt_down + (size_t)l * 1024 * FFN, 0, nullptr); }
        } else if (u < N_ADA + N_CONV + N_ROPE) {
            const int e = (u - N_ADA - N_CONV) * 256 + tid, pos = e / 48, a = e - pos * 48;
            const int row = pos >> 6, col = pos & 63;
            if (a < 16) { const float inv = exp2f(-(float)(a & 7) * (13.287712379549449f / 8.f)); const float ang = (float)(a < 8 ? row : col) * inv; float s, c; sincos_d((double)ang, s, c); p.cs16[((size_t)pos * 16 + a) * 2] = c; p.cs16[((size_t)pos * 16 + a) * 2 + 1] = s; }
            else { const int a2 = a - 16; const float inv = exp2f(-(float)(a2 & 15) * (13.287712379549449f / 16.f)); const float ang = (float)(a2 < 16 ? row : col) * inv; float s, c; sincos_d((double)ang, s, c); p.cs32[((size_t)pos * 32 + a2) * 2] = c; p.cs32[((size_t)pos * 32 + a2) * 2 + 1] = s; }
        } else {
            const int l = u - (N_ADA + N_CONV + N_ROPE); u32x4 z = {0, 0, 0, 0}; u32x4* d = (u32x4*)(p.wt_in + ((size_t)l * INW + 1952) * 1024);
            for (int i = tid; i < 96 * 1024 / 8; i += NTHREADS) d[i] = z;
        }
    }
}
__device__ __forceinline__ void phase_adareduce(const Params& p) {
    const int gt = blockIdx.x * NTHREADS + otid(), ntot = gridDim.x * NTHREADS;
    for (int i = gt; i < DEPTH * 3 * 6144; i += ntot) { const int l = i / (3 * 6144), r = i - l * 3 * 6144, v = r / 6144, col = r - v * 6144;
        float s = p.b_ada[l * 6144 + col];
#pragma unroll
        for (int kc = 0; kc < 16; ++kc) s += p.adapart[((size_t)(l * 16 + kc) * 3 + v) * 6144 + col];
        p.mod[i] = s; }
    if (gt < DEPTH) { const int l = gt; float a = 0.f, b = 0.f;
        for (int i = 0; i < 32; ++i) { a += p.lq1[l * 32 + i] * p.lk1[l * 32 + i]; b += p.lq2[l * 32 + i] * p.lk2[l * 32 + i]; }
        p.lam[l] = expf(a) - expf(b) + (0.8f - 0.6f * expf(-0.3f * (float)l)); }
}

#define XB_TMO      128
#define XB_XCNT(j)  (256  + 64 * (j))
#define XB_XSUB(j)  (1280 + 64 * (j))
#define XB_XGEN(j)  (2304 + 64 * (j))
#define XB_TOP      3328
#define XB_TOPGEN   3392
#define XCD_BAR_WORDS 3456
#define XB_SPIN_CAP (1u << 22)
#define LAS __attribute__((address_space(3)))
__device__ __forceinline__ unsigned xb_ld(unsigned* p)              { return __hip_atomic_load(p, __ATOMIC_RELAXED, __HIP_MEMORY_SCOPE_AGENT); }
__device__ __forceinline__ unsigned xb_add(unsigned* p, unsigned v) { return __hip_atomic_fetch_add(p, v, __ATOMIC_RELAXED, __HIP_MEMORY_SCOPE_AGENT); }
__device__ __forceinline__ unsigned xb_xcc_id() { return (unsigned)__builtin_amdgcn_s_getreg((3 << 11) | 20) & 0xFu; }
#define XB_SPIN(cond, bar) do { unsigned _sp = 0; while (cond) { __builtin_amdgcn_s_sleep(1); \
    if ((++_sp & 255u) == 0u) { if (xb_ld(&(bar)[XB_TMO])) break; if (_sp > XB_SPIN_CAP) { atomicAdd(&(bar)[XB_TMO], 1u); break; } } } } while (0)
struct XcdBarrier { unsigned* bar; unsigned x; volatile LAS unsigned* st; };
__device__ __forceinline__ XcdBarrier xcd_barrier_post(unsigned* bar, volatile LAS unsigned* st) {
    XcdBarrier b; b.bar = bar; b.x = xb_xcc_id(); b.st = st;
    if (threadIdx.x == 0) (void)xb_add(&bar[XB_XCNT(b.x)], 1u);
    return b;
}
__device__ __forceinline__ void xcd_barrier_complete(unsigned* bar, unsigned x, unsigned& nloc, unsigned& nx) {
    const unsigned G = gridDim.x * gridDim.y * gridDim.z;
    unsigned sum, cnt, mine, sp = 0u;
    for (;;) {
        sum = 0u; cnt = 0u; mine = 0u;
#pragma unroll
        for (unsigned j = 0; j < 16; ++j) { const unsigned c = xb_ld(&bar[XB_XCNT(j)]); sum += c; cnt += (c > 0u) ? 1u : 0u; mine = (j == x) ? c : mine; }
        if (sum == G) break;
        __builtin_amdgcn_s_sleep(1);
        if ((++sp & 255u) == 0u) { if (xb_ld(&bar[XB_TMO])) break; if (sp > XB_SPIN_CAP) { atomicAdd(&bar[XB_TMO], 1u); break; } }
    }
    nloc = mine > 0u ? mine : 1u; nx = cnt > 0u ? cnt : 1u;
}
__device__ __forceinline__ void xcd_barrier(const XcdBarrier& b) {
    asm volatile("s_waitcnt vmcnt(0)" ::: "memory");
    __syncthreads();
    if (threadIdx.x == 0) {
        unsigned* bar = b.bar;
        __builtin_amdgcn_s_waitcnt(0);
        unsigned nloc = b.st[0], nx = b.st[1];
        if (nloc == 0u) { xcd_barrier_complete(bar, b.x, nloc, nx); b.st[0] = nloc; b.st[1] = nx; }
        const unsigned old = xb_add(&bar[XB_XSUB(b.x)], 1u);
        const unsigned gen = old / nloc;
        if (old + 1u == (gen + 1u) * nloc) {
            __builtin_amdgcn_fence(__ATOMIC_RELEASE, "agent");
            asm volatile("s_waitcnt vmcnt(0)" ::: "memory");
            const unsigned og = xb_add(&bar[XB_TOP], 1u);
            const unsigned tg = og / nx;
            if (og + 1u == (tg + 1u) * nx) xb_add(&bar[XB_TOPGEN], 1u);
            else XB_SPIN(xb_ld(&bar[XB_TOPGEN]) == tg, bar);
            __builtin_amdgcn_fence(__ATOMIC_ACQUIRE, "agent");
            xb_add(&bar[XB_XGEN(b.x)], 1u);
            asm volatile("s_waitcnt vmcnt(0)" ::: "memory");
        } else {
            XB_SPIN(xb_ld(&bar[XB_XGEN(b.x)]) == gen, bar);
            __builtin_amdgcn_fence(__ATOMIC_ACQUIRE, "agent");
            asm volatile("s_waitcnt vmcnt(0)" ::: "memory");
        }
    }
    __syncthreads();
}

__device__ __forceinline__ void simple_barrier(unsigned* cnt, unsigned target) {
    asm volatile("s_waitcnt vmcnt(0)" ::: "memory");
    __syncthreads();
    if (threadIdx.x == 0) {
        __builtin_amdgcn_fence(__ATOMIC_RELEASE, "agent");
        asm volatile("s_waitcnt vmcnt(0)" ::: "memory");
        (void)__hip_atomic_fetch_add(cnt, 1u, __ATOMIC_RELAXED, __HIP_MEMORY_SCOPE_AGENT);
        unsigned sp = 0;
        while (__hip_atomic_load(cnt, __ATOMIC_RELAXED, __HIP_MEMORY_SCOPE_AGENT) < target) { __builtin_amdgcn_s_sleep(2); if (++sp > (1u << 24)) break; }
        __builtin_amdgcn_fence(__ATOMIC_ACQUIRE, "agent");
        asm volatile("s_waitcnt vmcnt(0)" ::: "memory");
    }
    __syncthreads();
}

constexpr int N_PHASES = 3 + 8 * DEPTH;
__global__ void __launch_bounds__(NTHREADS, 2) fwd_kernel(Params p) {
    extern __shared__ __attribute__((aligned(16))) unsigned char lds[];
    __shared__ uint4 xb_words;
    if (threadIdx.x == 0) xb_words = make_uint4(0u, 0u, 0u, 0u);
    __syncthreads();
    XcdBarrier xb = xcd_barrier_post(p.counters + 64, (volatile LAS unsigned*)&xb_words);
    for (int ph = p.phase_begin; ph < p.phase_end; ++ph) {
        if (ph == 0) phase_prologue(lds, p);
        else if (ph == 1) phase_adareduce(p);
        else if (ph == 2) phase_prenorm0(p);
        else {
            const int l = (ph - 3) >> 3, s = (ph - 3) & 7; const bool last = l == DEPTH - 1;
            if (s == 0) { EpiInProj e{&p, l}; gemm_phase(lds, p.wt_in + (size_t)l * INW * 1024, 1024, p.hbuf, DM, 1024, NT / 128, INW / 128, e); }
            else if (s == 1) {
                EpiMlaQ eq{&p}; EpiMlaKV ek{&p};
                const int nq = 136 * 3, nkv = 136 * 4;
                for (int u = blockIdx.x; u < nq + nkv; u += gridDim.x) { int tt, nt;
                    if (u < nq) { if (gemm_unit(u, NT / 128, 3, tt, nt)) gemm_tile(lds, p.wt_qb + (size_t)l * 384 * 256, 256, p.qkva, 384, 256, nt * 128, tt * 128, eq); }
                    else { if (gemm_unit(u - nq, NT / 128, 4, tt, nt)) gemm_tile(lds, p.wt_kvb + (size_t)l * 512 * 128, 128, p.qkva + 256, 384, 128, nt * 128, tt * 128, ek); } }
            }
            else if (s == 2) attn_phase(lds, p, l);
            else if (s == 3) gemm_phase_n1024(lds, p.wt_out + (size_t)l * 1024 * 1024, 1024, p.hbuf, DM, 1024, !last, (bf16_t*)p.Yf);
            else if (s == 4) phase_rowupdate(p, l, 0);
            else if (s == 5) { EpiSwiglu e{p.Gact}; gemm_phase(lds, p.wt_gu + (size_t)l * 2 * FFN * 1024, 1024, p.hbuf, DM, 1024, (last ? NLAT : NT) / 128, 44, e); }
            else if (s == 6) gemm_phase_n1024(lds, p.wt_down + (size_t)l * 1024 * FFN, FFN, p.Gact, FFN, FFN, !last, (bf16_t*)p.Yf);
            else phase_rowupdate(p, l, 1);
        }
        if (ph + 1 < p.phase_end) { if (p.coop == 1) xcd_barrier(xb); else if (p.coop == 3) simple_barrier(p.counters + 32, (unsigned)(ph - p.phase_begin + 1) * gridDim.x); else if (p.coop == 2) cg::this_grid().sync(); }
    }
}

extern "C" void kernel_launch(void* const* d_in, const int* in_sizes, int n_in, void* d_out, int out_size, void* d_ws, size_t ws_size, hipStream_t stream) {
    static int grid = 0;
    if (grid == 0) {
        int dev = 0, cus = 0, per_cu = 0;
        hipGetDevice(&dev); hipDeviceGetAttribute(&cus, hipDeviceAttributeMultiprocessorCount, dev);
        hipFuncSetAttribute((const void*)fwd_kernel, hipFuncAttributeMaxDynamicSharedMemorySize, LDS_BYTES);
        hipOccupancyMaxActiveBlocksPerMultiprocessor(&per_cu, (const void*)fwd_kernel, NTHREADS, LDS_BYTES);
        per_cu = 2;
        grid = cus * per_cu;
        fprintf(stderr, "kernel_launch: cus %d per_cu %d grid %d ws %zu\n", cus, per_cu, grid, ws_size);
    }
    Params p{};
    { const float* inp[26]; for (int i = 0; i < 26; ++i) inp[i] = (const float*)d_in[i]; memcpy((void*)&p, inp, sizeof(inp)); }
    p.out = (float*)d_out;
    unsigned char* w = (unsigned char*)d_ws; size_t off = 0;
    auto take = [&](size_t bytes) { unsigned char* r = w + off; off += (bytes + 255) & ~(size_t)255; return r; };
    p.counters = (unsigned*)take(256 + XCD_BAR_WORDS * 4);
    p.wt_in = (bf16_t*)take((size_t)2 * INW * 1024 * 2);
    p.wt_qb = (bf16_t*)take((size_t)2 * 384 * 256 * 2);
    p.wt_kvb = (bf16_t*)take((size_t)2 * 512 * 128 * 2);
    p.wt_out = (bf16_t*)take((size_t)2 * 1024 * 1024 * 2);
    p.wt_gu = (bf16_t*)take((size_t)2 * 2 * FFN * 1024 * 2);
    p.wt_down = (bf16_t*)take((size_t)2 * 1024 * FFN * 2);
    p.adapart = (float*)take((size_t)2 * 16 * 3 * 6144 * 4);
    p.mod = (float*)take((size_t)2 * 3 * 6144 * 4);
    p.lam = (float*)take(256);
    p.cs16 = (float*)take((size_t)SEQ * 16 * 2 * 4);
    p.cs32 = (float*)take((size_t)SEQ * 32 * 2 * 4);
    p.xc = (float*)take((size_t)NB * CTXL * DM * 4);
    p.ssq = (float*)take((size_t)NT * 8 * 4);
    p.hbuf = (bf16_t*)take((size_t)NT * DM * 2);
    p.Yf = (float*)take((size_t)NT * DM * 4); p.qkva = (bf16_t*)p.Yf;
    unsigned char* ra = take((size_t)NT * FFN * 2); p.Gact = (bf16_t*)ra;
    { size_t o2 = 0; auto tk = [&](size_t bytes) { unsigned char* r = ra + o2; o2 += (bytes + 255) & ~(size_t)255; return (bf16_t*)r; };
      p.Qm = tk((size_t)NB * 4 * NKEY * 96 * 2); p.Km = tk((size_t)NB * 4 * NKEY * 96 * 2); p.VmT = tk((size_t)NB * 4 * 64 * NKEY * 2);
      p.Qd = tk((size_t)NB * 8 * NKEY * 32 * 2); p.Kd = tk((size_t)NB * 8 * NKEY * 32 * 2); p.VdT = tk((size_t)NB * 4 * 64 * NKEY * 2);
      p.Qg = tk((size_t)NB * 8 * NKEY * 64 * 2); p.Kg = tk((size_t)NB * 2 * NKEY * 64 * 2); p.VgT = tk((size_t)NB * 2 * 64 * NKEY * 2);
      if (o2 > (size_t)NT * FFN * 2) { fprintf(stderr, "kernel_launch: region RA overflow\n"); return; } }
    if (off > ws_size) { fprintf(stderr, "kernel_launch: workspace too small: need %zu have %zu\n", off, ws_size); return; }
    (void)hipMemsetAsync(p.counters, 0, 256 + XCD_BAR_WORDS * 4, stream);
#if ONE_LAUNCH
    p.phase_begin = 0; p.phase_end = N_PHASES; p.coop = 1;
    void* args[] = {&p};
    hipError_t e = hipLaunchCooperativeKernel((const void*)fwd_kernel, dim3(grid), dim3(NTHREADS), args, LDS_BYTES, stream);
    if (e != hipSuccess) fprintf(stderr, "cooperative launch failed: %s (grid %d)\n", hipGetErrorString(e), grid);
#else
    for (int ph = 0; ph < N_PHASES; ++ph) { p.phase_begin = ph; p.phase_end = ph + 1; p.coop = 0; hipLaunchKernelGGL(fwd_kernel, dim3(grid), dim3(NTHREADS), LDS_BYTES, stream, p); }
#endif
}
```
